# Optimizing an MI355X kernel written in HIP

```python
import math
import jax, jax.numpy as jnp
from jax import lax
import numpy as np

D_MODEL = 2048
BATCH = 16
SEQ = 256
DEPTH = 4
DEC_BATCH = 4
DEC_SEQ = 1024
PAST_LEN = 512

GRID_W = 64
N_MIXERS = 4
N_LAYERS_A = (DEPTH + N_MIXERS - 1) // N_MIXERS
N_LAYERS_B = (DEPTH + N_MIXERS - 2) // N_MIXERS
N_LAYERS_C = (DEPTH + N_MIXERS - 3) // N_MIXERS
N_LAYERS_D = (DEPTH + N_MIXERS - 4) // N_MIXERS
D_FF = 4 * D_MODEL
N_MOD = 6
RMS_EPS = 1e-6
ROPE_THETA = 10000.0
Q_BLOCK = 128

A_HEADS = 16
A_HALF_DIM = D_MODEL // A_HEADS // 2
A_V_DIM = 2 * A_HALF_DIM

B_HEADS = 8
B_DK = D_MODEL // 2 // B_HEADS
B_DV = D_MODEL // B_HEADS
B_CHUNK = 64
B_IN = 2 * B_HEADS * B_DK + 2 * B_HEADS * B_DV + 4 * B_HEADS

C_HEADS = 16
C_HEAD_DIM = D_MODEL // C_HEADS
NA_ROWS_MAX = 8
NA_COLS = 16
NA_QCOLS = 16
NA_KCOLS = 32

D_HEADS = 32
D_KV_HEADS = 8
D_GROUP = D_HEADS // D_KV_HEADS
D_HEAD_DIM = D_MODEL // D_HEADS
WINDOW = 128

kernel_name = 'hybrid_diffusion_trunk_step'


def rmsnorm(x, g):
    xf = x.astype(jnp.float32)
    y = xf * lax.rsqrt(jnp.mean(xf * xf, axis=-1, keepdims=True) + RMS_EPS)
    return (y * g.astype(jnp.float32)).astype(x.dtype)


def adaln_in(x, g, shift, scale):
    return rmsnorm(x, g) * (1.0 + scale) + shift


def modulation(cvec, w, b):
    m = (jax.nn.silu(cvec) @ w + b)[:, None, :]
    return jnp.split(m, N_MOD, axis=-1)


def sqrelu_mlp(h, w1, w2):
    return jnp.square(jax.nn.relu(h @ w1)) @ w2


def rope_half(x, pos):
    half = x.shape[-1] // 2
    inv = ROPE_THETA ** (-jnp.arange(half, dtype=jnp.float32) / half)
    ang = pos.astype(jnp.float32)[:, None] * inv
    ang = ang.reshape((pos.shape[0],) + (1,) * (x.ndim - 3) + (half,))
    cos, sin = jnp.cos(ang).astype(x.dtype), jnp.sin(ang).astype(x.dtype)
    x1, x2 = x[..., :half], x[..., half:]
    return jnp.concatenate([x1 * cos - x2 * sin, x1 * sin + x2 * cos], axis=-1)


def axial_rope(x):
    t = jnp.arange(x.shape[1])
    d = x.shape[-1] // 2
    return jnp.concatenate([rope_half(x[..., :d], t // GRID_W), rope_half(x[..., d:], t % GRID_W)], axis=-1)


def map_query_blocks(fn, q):
    B, T = q.shape[:2]
    nb = T // Q_BLOCK
    qb = jnp.swapaxes(q.reshape((B, nb, Q_BLOCK) + q.shape[2:]), 0, 1)
    out = lax.map(fn, (qb, jnp.arange(nb)))
    return jnp.swapaxes(out, 0, 1).reshape((B, T) + out.shape[3:])


def softmax_attn_block(qb, k, v):
    s = jnp.einsum('bqhd,bkhd->bhqk', qb, k, preferred_element_type=jnp.float32) * (qb.shape[-1] ** -0.5)
    p = jax.nn.softmax(s, axis=-1)
    return jnp.einsum('bhqk,bkhd->bqhd', p.astype(v.dtype), v)


def diff_split(h, w_in):
    B, T, _ = h.shape
    q, k, v = jnp.split(h @ w_in, 3, axis=-1)
    return (q.reshape(B, T, A_HEADS, 2, A_HALF_DIM), k.reshape(B, T, A_HEADS, 2, A_HALF_DIM),
            v.reshape(B, T, A_HEADS, A_V_DIM))


def diff_lambda(lam_p, lam_init):
    lp = lam_p.astype(jnp.float32)
    return jnp.exp(jnp.sum(lp[0] * lp[1], -1)) - jnp.exp(jnp.sum(lp[2] * lp[3], -1)) + lam_init


def diff_core(qb, k, v, lam):
    s = jnp.einsum('bqhjd,bkhjd->bhjqk', qb, k, preferred_element_type=jnp.float32) * (A_HALF_DIM ** -0.5)
    p = jax.nn.softmax(s, axis=-1)
    a = p[:, :, 0] - lam[None, :, None, None] * p[:, :, 1]
    return jnp.einsum('bhqk,bkhd->bqhd', a.astype(v.dtype), v)


def diff_out(o, subln, lam_init, w_out):
    B, T = o.shape[:2]
    return (rmsnorm(o, subln) * (1.0 - lam_init)).reshape(B, T, -1) @ w_out


def diff_attn_context(h, w_in, w_out, lam_p, subln, lam_init):
    B, T, _ = h.shape
    q, k, v = diff_split(h, w_in)
    lam = diff_lambda(lam_p, lam_init)
    o = map_query_blocks(lambda a: diff_core(a[0], k, v, lam), q)
    return diff_out(o, subln, lam_init, w_out), k.reshape(B, T, A_HEADS, A_V_DIM), v


def diff_attn_latent(h, ck, cv, w_in, w_out, lam_p, subln, lam_init):
    B, T, _ = h.shape
    q, k, v = diff_split(h, w_in)
    q, k = axial_rope(q), axial_rope(k)
    kk = jnp.concatenate([ck.reshape(B, ck.shape[1], A_HEADS, 2, A_HALF_DIM).astype(k.dtype), k], axis=1)
    vv = jnp.concatenate([cv.astype(v.dtype), v], axis=1)
    lam = diff_lambda(lam_p, lam_init)
    o = map_query_blocks(lambda a: diff_core(a[0], kk, vv, lam), q)
    return diff_out(o, subln, lam_init, w_out)


def mlstm_chunked(q, k, v, ig, lf, C0, n0, m0):
    B, T = q.shape[:2]
    L = B_CHUNK
    nc = T // L

    def to_chunks(a):
        return jnp.swapaxes(a.reshape((B, nc, L) + a.shape[2:]), 0, 1)

    xs = (to_chunks(q), to_chunks(k), to_chunks(v), to_chunks(ig), to_chunks(lf))
    causal = jnp.tril(jnp.ones((L, L), dtype=bool))

    def step(carry, xc):
        C, n, m = carry
        qc, kc, vc, ic, fc = xc
        b = jnp.cumsum(fc, axis=1)
        dm = b[:, :, None, :] - b[:, None, :, :] + ic[:, None, :, :]
        dm = jnp.where(causal[None, :, :, None], dm, -jnp.inf)
        inter = b + m[:, None, :]
        m_t = jnp.maximum(inter, jnp.max(dm, axis=2))
        w = jnp.exp(dm - m_t[:, :, None, :])
        a_in = jnp.exp(inter - m_t)
        sw = jnp.einsum('bthd,bshd->btsh', qc, kc, preferred_element_type=jnp.float32) * w
        num = (jnp.einsum('btsh,bshv->bthv', sw, vc, preferred_element_type=jnp.float32)
               + a_in[..., None] * jnp.einsum('bhvd,bthd->bthv', C, qc, preferred_element_type=jnp.float32))
        den = jnp.sum(sw, axis=2) + a_in * jnp.einsum('bhd,bthd->bth', n, qc, preferred_element_type=jnp.float32)
        h = num / jnp.maximum(jnp.abs(den), jnp.exp(-m_t))[..., None]
        wl, al = w[:, -1], a_in[:, -1]
        C_new = al[..., None, None] * C + jnp.einsum('bsh,bshv,bshd->bhvd', wl, vc, kc, preferred_element_type=jnp.float32)
        n_new = al[..., None] * n + jnp.einsum('bsh,bshd->bhd', wl, kc, preferred_element_type=jnp.float32)
        return (C_new, n_new, m_t[:, -1]), h

    init = (C0.astype(jnp.float32), n0.astype(jnp.float32), m0.astype(jnp.float32))
    (C, n, m), hs = lax.scan(step, init, xs)
    hs = jnp.swapaxes(hs, 0, 1).reshape(B, T, B_HEADS, B_DV)
    return hs, C, n, m


def mlstm_proj(h, w_in, gate_bias):
    B, T, _ = h.shape
    qk, vd = B_HEADS * B_DK, B_HEADS * B_DV
    q, k, v, o, g = jnp.split(h @ w_in, [qk, 2 * qk, 2 * qk + vd, 2 * qk + 2 * vd], axis=-1)
    q = q.reshape(B, T, B_HEADS, B_DK) * (B_DK ** -0.5)
    k = k.reshape(B, T, B_HEADS, B_DK)
    v = v.reshape(B, T, B_HEADS, B_DV)
    g = g.astype(jnp.float32).reshape(B, T, 4, B_HEADS) + gate_bias.astype(jnp.float32)
    return q, k, v, o, g


def _rev(a, d):
    return a if d == 0 else jnp.flip(a, axis=1)


def mlstm_bidir(q, k, v, g, C0, n0, m0):
    hsum, Cs, ns, ms = 0.0, [], [], []
    for d in range(2):
        ig = g[:, :, 2 * d]
        lf = jax.nn.log_sigmoid(g[:, :, 2 * d + 1])
        hd, Cd, nd, md = mlstm_chunked(_rev(q, d), _rev(k, d), _rev(v, d), _rev(ig, d), _rev(lf, d),
                                       C0[:, d], n0[:, d], m0[:, d])
        hsum = hsum + _rev(hd, d)
        Cs.append(Cd); ns.append(nd); ms.append(md)
    return hsum, jnp.stack(Cs, axis=1), jnp.stack(ns, axis=1), jnp.stack(ms, axis=1)


def mlstm_out(hsum, o, norm_w, w_out):
    B, T = hsum.shape[:2]
    hn = rmsnorm(hsum.astype(o.dtype), norm_w.reshape(B_HEADS, B_DV))
    return (hn.reshape(B, T, -1) * jax.nn.sigmoid(o)) @ w_out


def mlstm_context(h, w_in, gate_bias, norm_w, w_out):
    B = h.shape[0]
    q, k, v, o, g = mlstm_proj(h, w_in, gate_bias)
    C0 = jnp.zeros((B, 2, B_HEADS, B_DV, B_DK), jnp.float32)
    n0 = jnp.zeros((B, 2, B_HEADS, B_DK), jnp.float32)
    m0 = jnp.zeros((B, 2, B_HEADS), jnp.float32)
    hsum, C, n, m = mlstm_bidir(q, k, v, g, C0, n0, m0)
    return mlstm_out(hsum, o, norm_w, w_out), C, n, m


def mlstm_latent(h, C0, n0, m0, w_in, gate_bias, norm_w, w_out):
    q, k, v, o, g = mlstm_proj(h, w_in, gate_bias)
    hsum, _, _, _ = mlstm_bidir(q, k, v, g, C0, n0, m0)
    return mlstm_out(hsum, o, norm_w, w_out)


def na_split(h, w_in):
    B, T, _ = h.shape
    q, k, v = jnp.split(h @ w_in, 3, axis=-1)
    return tuple(a.reshape(B, T, C_HEADS, C_HEAD_DIM) for a in (q, k, v))


def na_context(h, w_in, w_out):
    B, T, _ = h.shape
    q, k, v = na_split(h, w_in)
    o = map_query_blocks(lambda a: softmax_attn_block(a[0], k, v), q)
    return o.reshape(B, T, -1) @ w_out, k, v


def na_latent(h, ck, cv, w_in, w_out, rpb):
    B, T, _ = h.shape
    rows = T // GRID_W
    kh = min(NA_ROWS_MAX, rows)
    q, k, v = na_split(h, w_in)
    ck, cv = ck.astype(k.dtype), cv.astype(v.dtype)
    qg = q.reshape(B, rows, GRID_W, C_HEADS, C_HEAD_DIM)
    kg = k.reshape(B, rows, GRID_W, C_HEADS, C_HEAD_DIM)
    vg = v.reshape(B, rows, GRID_W, C_HEADS, C_HEAD_DIM)
    ncb = GRID_W // NA_QCOLS
    col0 = np.clip(np.arange(ncb) * NA_QCOLS - NA_COLS // 2, 0, GRID_W - NA_KCOLS)
    kcols = col0[:, None] + np.arange(NA_KCOLS)
    qcols = np.arange(ncb)[:, None] * NA_QCOLS + np.arange(NA_QCOLS)
    cstart = np.clip(qcols - NA_COLS // 2, 0, GRID_W - NA_COLS)
    col_ok = (kcols[:, None, :] >= cstart[..., None]) & (kcols[:, None, :] < cstart[..., None] + NA_COLS)
    dcol = np.clip(kcols[:, None, :] - qcols[..., None], -(NA_COLS - 1), NA_COLS - 1) + NA_COLS - 1
    bias_col = rpb.astype(jnp.float32)[:, :, dcol]
    n_nb = kh * NA_KCOLS
    scale = C_HEAD_DIM ** -0.5

    def row_fn(a):
        qr, r = a
        r0 = jnp.clip(r - kh // 2, 0, rows - kh)
        kr = lax.dynamic_slice_in_dim(kg, r0, kh, axis=1)[:, :, kcols]
        vr = lax.dynamic_slice_in_dim(vg, r0, kh, axis=1)[:, :, kcols]
        qb = qr.reshape(B, ncb, NA_QCOLS, C_HEADS, C_HEAD_DIM)
        s_nb = jnp.einsum('bjqhd,bijkhd->bhjqik', qb, kr, preferred_element_type=jnp.float32) * scale
        drow = r0 + jnp.arange(kh) - r + NA_ROWS_MAX - 1
        bias = jnp.transpose(jnp.take(bias_col, drow, axis=1), (0, 2, 3, 1, 4))
        s_nb = jnp.where(col_ok[:, :, None, :], s_nb + bias, -jnp.inf)
        s_ctx = jnp.einsum('bjqhd,bkhd->bhjqk', qb, ck, preferred_element_type=jnp.float32) * scale
        p = jax.nn.softmax(jnp.concatenate([s_nb.reshape(B, C_HEADS, ncb, NA_QCOLS, n_nb), s_ctx], axis=-1), axis=-1)
        p = p.astype(v.dtype)
        p_nb = p[..., :n_nb].reshape(B, C_HEADS, ncb, NA_QCOLS, kh, NA_KCOLS)
        o = (jnp.einsum('bhjqik,bijkhd->bjqhd', p_nb, vr)
             + jnp.einsum('bhjqk,bkhd->bjqhd', p[..., n_nb:], cv))
        return o.reshape(B, GRID_W, C_HEADS, C_HEAD_DIM)

    o = lax.map(row_fn, (jnp.swapaxes(qg, 0, 1), jnp.arange(rows)))
    return jnp.swapaxes(o, 0, 1).reshape(B, T, -1) @ w_out


def gqa_split(h, w_in):
    B, T, _ = h.shape
    q, k, v = jnp.split(h @ w_in, [D_HEADS * D_HEAD_DIM, (D_HEADS + D_KV_HEADS) * D_HEAD_DIM], axis=-1)
    return (q.reshape(B, T, D_KV_HEADS, D_GROUP, D_HEAD_DIM), k.reshape(B, T, D_KV_HEADS, D_HEAD_DIM),
            v.reshape(B, T, D_KV_HEADS, D_HEAD_DIM))


def sink_probs(s, sk):
    skb = sk[None, :, :, None, None]
    m = jnp.maximum(jnp.max(s, axis=-1, keepdims=True), skb)
    e = jnp.exp(s - m)
    return e / (jnp.sum(e, axis=-1, keepdims=True) + jnp.exp(skb - m))


def gqa_context(h, w_in, w_out, sink):
    B, T, _ = h.shape
    q, k, v = gqa_split(h, w_in)
    sk = sink.astype(jnp.float32).reshape(D_KV_HEADS, D_GROUP)

    def blk(a):
        s = jnp.einsum('bqhgd,bkhd->bhgqk', a[0], k, preferred_element_type=jnp.float32) * (D_HEAD_DIM ** -0.5)
        return jnp.einsum('bhgqk,bkhd->bqhgd', sink_probs(s, sk).astype(v.dtype), v)

    o = map_query_blocks(blk, q)
    return o.reshape(B, T, -1) @ w_out, k, v


def gqa_latent(h, ck, cv, w_in, w_out, sink):
    B, T, _ = h.shape
    q, k, v = gqa_split(h, w_in)
    q, k = axial_rope(q), axial_rope(k)
    ck, cv = ck.astype(k.dtype), cv.astype(v.dtype)
    pad = ((0, 0), (Q_BLOCK, Q_BLOCK), (0, 0), (0, 0))
    kp, vp = jnp.pad(k, pad), jnp.pad(v, pad)
    band = 3 * Q_BLOCK
    sk = sink.astype(jnp.float32).reshape(D_KV_HEADS, D_GROUP)
    scale = D_HEAD_DIM ** -0.5

    def blk(a):
        qb, bi = a
        kb = lax.dynamic_slice_in_dim(kp, bi * Q_BLOCK, band, axis=1)
        vb = lax.dynamic_slice_in_dim(vp, bi * Q_BLOCK, band, axis=1)
        qpos = bi * Q_BLOCK + jnp.arange(Q_BLOCK)
        kpos = (bi - 1) * Q_BLOCK + jnp.arange(band)
        valid = (kpos[None, :] >= 0) & (kpos[None, :] < T) & (jnp.abs(qpos[:, None] - kpos[None, :]) <= WINDOW)
        s_loc = jnp.einsum('bqhgd,bkhd->bhgqk', qb, kb, preferred_element_type=jnp.float32) * scale
        s_loc = jnp.where(valid, s_loc, -jnp.inf)
        s_ctx = jnp.einsum('bqhgd,bkhd->bhgqk', qb, ck, preferred_element_type=jnp.float32) * scale
        p = sink_probs(jnp.concatenate([s_loc, s_ctx], axis=-1), sk).astype(v.dtype)
        return (jnp.einsum('bhgqk,bkhd->bqhgd', p[..., :band], vb)
                + jnp.einsum('bhgqk,bkhd->bqhgd', p[..., band:], cv))

    o = map_query_blocks(blk, q)
    return o.reshape(B, T, -1) @ w_out


def setup_inputs(seed: int = 0) -> dict:
    key = jax.random.key(seed)
    ks = jax.random.split(key, 40)
    D = D_MODEL

    def nrm(i, shape, s=1.0):
        return s * jax.random.normal(ks[i], shape, jnp.float32)

    return {
        'x_prompt': nrm(0, (BATCH, SEQ, D)),
        'x_sample': nrm(1, (DEC_BATCH, DEC_SEQ, D)),
        'cache_a_k': nrm(2, (DEC_BATCH, N_LAYERS_A, PAST_LEN, A_HEADS, A_V_DIM)),
        'cache_a_v': nrm(3, (DEC_BATCH, N_LAYERS_A, PAST_LEN, A_HEADS, A_V_DIM)),
        'state_b_C': nrm(4, (DEC_BATCH, N_LAYERS_B, 2, B_HEADS, B_DV, B_DK)),
        'state_b_n': nrm(5, (DEC_BATCH, N_LAYERS_B, 2, B_HEADS, B_DK)),
        'state_b_m': nrm(6, (DEC_BATCH, N_LAYERS_B, 2, B_HEADS)),
        'cache_c_k': nrm(7, (DEC_BATCH, N_LAYERS_C, PAST_LEN, C_HEADS, C_HEAD_DIM)),
        'cache_c_v': nrm(8, (DEC_BATCH, N_LAYERS_C, PAST_LEN, C_HEADS, C_HEAD_DIM)),
        'cache_d_k': nrm(9, (DEC_BATCH, N_LAYERS_D, PAST_LEN, D_KV_HEADS, D_HEAD_DIM)),
        'cache_d_v': nrm(10, (DEC_BATCH, N_LAYERS_D, PAST_LEN, D_KV_HEADS, D_HEAD_DIM)),
        'c': nrm(11, (DEC_BATCH, D)),
        'c_ctx': nrm(12, (D,)),
        'w_mod': nrm(13, (DEPTH, D, N_MOD * D), 0.5 * D ** -0.5),
        'b_mod': nrm(14, (DEPTH, N_MOD * D), 0.01),
        'g_norm': 1.0 + nrm(15, (DEPTH, 4, D), 0.05),
        'w_ff1': nrm(16, (DEPTH, D, D_FF), D ** -0.5),
        'w_ff2': nrm(17, (DEPTH, D_FF, D), D_FF ** -0.5),
        'a_w_in': nrm(18, (N_LAYERS_A, D, 3 * A_HEADS * A_V_DIM), D ** -0.5),
        'a_w_out': nrm(19, (N_LAYERS_A, A_HEADS * A_V_DIM, D), (A_HEADS * A_V_DIM) ** -0.5),
        'a_lambda': nrm(20, (N_LAYERS_A, 4, A_HEADS, A_HALF_DIM), 0.1),
        'a_subln': 1.0 + nrm(21, (N_LAYERS_A, A_V_DIM), 0.05),
        'b_w_in': nrm(22, (N_LAYERS_B, D, B_IN), D ** -0.5),
        'b_gate_bias': nrm(23, (N_LAYERS_B, 4, B_HEADS), 0.1) + jnp.array([0.0, 3.0, 0.0, 3.0], jnp.float32)[None, :, None],
        'b_w_out': nrm(24, (N_LAYERS_B, B_HEADS * B_DV, D), (B_HEADS * B_DV) ** -0.5),
        'b_norm': 1.0 + nrm(25, (N_LAYERS_B, B_HEADS * B_DV), 0.05),
        'c_w_in': nrm(26, (N_LAYERS_C, D, 3 * C_HEADS * C_HEAD_DIM), D ** -0.5),
        'c_w_out': nrm(27, (N_LAYERS_C, C_HEADS * C_HEAD_DIM, D), (C_HEADS * C_HEAD_DIM) ** -0.5),
        'c_rpb': nrm(28, (N_LAYERS_C, C_HEADS, 2 * NA_ROWS_MAX - 1, 2 * NA_COLS - 1), 0.5),
        'd_w_in': nrm(29, (N_LAYERS_D, D, (D_HEADS + 2 * D_KV_HEADS) * D_HEAD_DIM), D ** -0.5),
        'd_w_out': nrm(30, (N_LAYERS_D, D_HEADS * D_HEAD_DIM, D), (D_HEADS * D_HEAD_DIM) ** -0.5),
        'd_sink': nrm(31, (N_LAYERS_D, D_HEADS)),
    }


def reference(x_prompt, x_sample, cache_a_k, cache_a_v, state_b_C, state_b_n, state_b_m,
              cache_c_k, cache_c_v, cache_d_k, cache_d_v, c, c_ctx, w_mod, b_mod, g_norm,
              w_ff1, w_ff2, a_w_in, a_w_out, a_lambda, a_subln, b_w_in, b_gate_bias, b_w_out,
              b_norm, c_w_in, c_w_out, c_rpb, d_w_in, d_w_out, d_sink):
    xp, xs = x_prompt, x_sample
    a_k, a_v, b_C, b_n, b_m, c_k, c_v, d_k, d_v = [], [], [], [], [], [], [], [], []
    for i in range(DEPTH):
        kind, j = i % N_MIXERS, i // N_MIXERS
        mod_p = modulation(c_ctx[None, :], w_mod[i], b_mod[i])
        mod_s = modulation(c, w_mod[i], b_mod[i])
        hp = adaln_in(xp, g_norm[i, 0], mod_p[0], mod_p[1])
        hs = adaln_in(xs, g_norm[i, 0], mod_s[0], mod_s[1])
        if kind == 0:
            lam_init = 0.8 - 0.6 * math.exp(-0.3 * i)
            yp, kc, vc = diff_attn_context(hp, a_w_in[j], a_w_out[j], a_lambda[j], a_subln[j], lam_init)
            ys = diff_attn_latent(hs, cache_a_k[:, j], cache_a_v[:, j], a_w_in[j], a_w_out[j],
                                  a_lambda[j], a_subln[j], lam_init)
            a_k.append(kc); a_v.append(vc)
        elif kind == 1:
            yp, Cc, nc_, mc = mlstm_context(hp, b_w_in[j], b_gate_bias[j], b_norm[j], b_w_out[j])
            ys = mlstm_latent(hs, state_b_C[:, j], state_b_n[:, j], state_b_m[:, j],
                              b_w_in[j], b_gate_bias[j], b_norm[j], b_w_out[j])
            b_C.append(Cc); b_n.append(nc_); b_m.append(mc)
        elif kind == 2:
            yp, kc, vc = na_context(hp, c_w_in[j], c_w_out[j])
            ys = na_latent(hs, cache_c_k[:, j], cache_c_v[:, j], c_w_in[j], c_w_out[j], c_rpb[j])
            c_k.append(kc); c_v.append(vc)
        else:
            yp, kc, vc = gqa_context(hp, d_w_in[j], d_w_out[j], d_sink[j])
            ys = gqa_latent(hs, cache_d_k[:, j], cache_d_v[:, j], d_w_in[j], d_w_out[j], d_sink[j])
            d_k.append(kc); d_v.append(vc)
        xp = xp + mod_p[2] * rmsnorm(yp, g_norm[i, 1])
        xs = xs + mod_s[2] * rmsnorm(ys, g_norm[i, 1])
        hp = adaln_in(xp, g_norm[i, 2], mod_p[3], mod_p[4])
        hs = adaln_in(xs, g_norm[i, 2], mod_s[3], mod_s[4])
        xp = xp + mod_p[5] * rmsnorm(sqrelu_mlp(hp, w_ff1[i], w_ff2[i]), g_norm[i, 3])
        xs = xs + mod_s[5] * rmsnorm(sqrelu_mlp(hs, w_ff1[i], w_ff2[i]), g_norm[i, 3])
    return (xp, xs, jnp.stack(a_k, axis=1), jnp.stack(a_v, axis=1), jnp.stack(b_C, axis=1),
            jnp.stack(b_n, axis=1), jnp.stack(b_m, axis=1), jnp.stack(c_k, axis=1),
            jnp.stack(c_v, axis=1), jnp.stack(d_k, axis=1), jnp.stack(d_v, axis=1))
```

```cpp
#include <hip/hip_runtime.h>
#include <cstdio>
#include <cstdint>
#include <cmath>
namespace pg8 {
#define PG8_LAS __attribute__((address_space(3)))
typedef unsigned short bf16_t;
typedef short bf16x8 __attribute__((ext_vector_type(8)));
typedef float f32x4 __attribute__((ext_vector_type(4)));
typedef unsigned u32x4 __attribute__((ext_vector_type(4)));
constexpr int BM = 256, BK = 64, HALF = 128, HTB = HALF * BK * 2  , STAGE_BYTES = 8 * HTB, NXCD = 8, WGM = 8;

__host__ __device__ __forceinline__ int lds_byte(int r, int c) { const int st = (r >> 4) * 2 + (c >> 5), rr = r & 15, cc = c & 31, ob = rr * 64 + cc * 2; return st * 1024 + (ob ^ (((ob >> 9) & 1) << 5)); }
__host__ __device__ __forceinline__ void stage_rc(int b, int& R, int& C) { const int st = b / 1024, sb = b % 1024, swz = sb ^ (((sb >> 9) & 1) << 5); R = (st >> 1) * 16 + swz / 64; C = (st & 1) * 32 + (swz % 64) / 2; }
__host__ __device__ __forceinline__ int perm32(int rho) { const int n = rho >> 4, i = rho & 15; return 8 * (i >> 2) + 4 * n + (i & 3); }

struct Unit { int pm, pn; };
struct Gemm { const bf16_t* A; const bf16_t* Bt; int M, N, K; };

struct StaticOrder {
    int nM, nN, nwg, G, c;
    __host__ __device__ void init(int M, int N, int G_, int c_) { nM = M / BM; nN = N / BM; nwg = nM * nN; G = G_; c = c_; }
    __host__ __device__ bool next(int i, Unit& u) const {
        const long L = (long)i * G + c; if (L >= nwg) return false;
        int wgid = (int)L; { const int q = nwg / NXCD, r = nwg % NXCD, xcd = wgid % NXCD, off = wgid / NXCD; wgid = (xcd < r ? xcd * (q + 1) : r * (q + 1) + (xcd - r) * q) + off; }
        const int nig = WGM * nN, gid = wgid / nig, fm = gid * WGM, gsz = (nM - fm) < WGM ? (nM - fm) : WGM;
        u.pm = fm + ((wgid % nig) % gsz); u.pn = (wgid % nig) / gsz; return true;
    }
    __device__ __forceinline__ void a_ready(const Unit&) const {}
    __device__ __forceinline__ void done(const Unit&) const {}
};

__device__ __forceinline__ unsigned cvt_pk_bf16(float lo, float hi) { unsigned r; asm volatile("v_cvt_pk_bf16_f32 %0, %1, %2" : "=v"(r) : "v"(lo), "v"(hi)); return r; }
typedef float f32x2 __attribute__((ext_vector_type(2)));

struct EpiF32 {
    static constexpr bool PERM = false, AFTER_DRAIN = false;
    float* C; int ldc;
    __device__ __forceinline__ void operator()(const f32x4 (&acc)[2][2][4][2], const Unit& u, int wr, int wc, int fr, int fq) const {
        const int row0 = u.pm * BM + wr * 64 + fr, col0 = u.pn * BM + wc * 32 + 4 * fq;
#pragma unroll
        for (int ai = 0; ai < 2; ++ai)
#pragma unroll
            for (int m = 0; m < 4; ++m) { float* rowp = C + (size_t)(row0 + ai * HALF + m * 16) * ldc + col0;
#pragma unroll
                for (int bj = 0; bj < 2; ++bj)
#pragma unroll
                    for (int n = 0; n < 2; ++n) *(f32x4*)(rowp + bj * HALF + n * 16) = acc[ai][bj][m][n]; }
    }
};
struct EpiSqRelu {
    static constexpr bool PERM = true, AFTER_DRAIN = false;
    bf16_t* O; int ldc;
    __device__ __forceinline__ void operator()(const f32x4 (&acc)[2][2][4][2], const Unit& u, int wr, int wc, int fr, int fq) const {
        const int row0 = u.pm * BM + wr * 64 + fr, col0 = u.pn * BM + wc * 32 + 8 * fq;
#pragma unroll
        for (int ai = 0; ai < 2; ++ai)
#pragma unroll
            for (int m = 0; m < 4; ++m) { bf16_t* rowp = O + (size_t)(row0 + ai * HALF + m * 16) * ldc + col0;
#pragma unroll
                for (int bj = 0; bj < 2; ++bj) { f32x4 v0 = acc[ai][bj][m][0], v1 = acc[ai][bj][m][1];
#pragma unroll
                    for (int e = 0; e < 4; ++e) { const float a = fmaxf(v0[e], 0.f), b = fmaxf(v1[e], 0.f); v0[e] = a * a; v1[e] = b * b; }
                    u32x4 w; w.x = cvt_pk_bf16(v0[0], v0[1]); w.y = cvt_pk_bf16(v0[2], v0[3]); w.z = cvt_pk_bf16(v1[0], v1[1]); w.w = cvt_pk_bf16(v1[2], v1[3]);
                    *(u32x4*)(rowp + bj * HALF) = w; } }
    }
};
struct EpiInProj {
    static constexpr bool PERM = true, AFTER_DRAIN = false;
    bf16_t* O; int ldc;
    float* ck; float* cv;
    int kc0, vc0, kw;
    int rope_cols;
    const float* rtab;
    __device__ __forceinline__ void operator()(const f32x4 (&acc)[2][2][4][2], const Unit& u, int wr, int wc, int fr, int fq) const {
        const int row0 = u.pm * BM + wr * 64 + fr, colt = u.pn * BM, col0 = colt + wc * 32 + 8 * fq;
        float* cdst = nullptr; int ccol = 0;
        if (u.pm < 16 && ck != nullptr) {
            if (colt >= kc0 && colt < kc0 + kw) { cdst = ck; ccol = col0 - kc0; }
            else if (colt >= vc0 && colt < vc0 + kw) { cdst = cv; ccol = col0 - vc0; }
        }
        const bool rope = (u.pm >= 16) && (colt < rope_cols);
#pragma unroll
        for (int ai = 0; ai < 2; ++ai)
#pragma unroll
            for (int m = 0; m < 4; ++m) {
                const int row = row0 + ai * HALF + m * 16;
                bf16_t* rowp = O + (size_t)row * ldc + col0;
                int pos = 0; if (rope) { const int t = row & 1023; pos = (wc & 1) ? (t & 63) : (t >> 6); }
                const f32x4* tb = (const f32x4*)(rtab + (pos * 16 + 8 * (fq & 1)) * 2);
#pragma unroll
                for (int bj = 0; bj < 2; ++bj) { f32x4 v0 = acc[ai][bj][m][0], v1 = acc[ai][bj][m][1];
                    if (rope) {
                        const f32x4 t0 = tb[0], t1 = tb[1], t2 = tb[2], t3 = tb[3];
                        const float cs[8] = {t0[0], t0[2], t1[0], t1[2], t2[0], t2[2], t3[0], t3[2]};
                        const float sn[8] = {t0[1], t0[3], t1[1], t1[3], t2[1], t2[3], t3[1], t3[3]};
#pragma unroll
                        for (int e = 0; e < 4; ++e) {
                            const float a = v0[e], pa = __shfl_xor(a, 32), b = v1[e], pb = __shfl_xor(b, 32);
                            v0[e] = (fq < 2) ? a * cs[e] - pa * sn[e] : pa * sn[e] + a * cs[e];
                            v1[e] = (fq < 2) ? b * cs[4 + e] - pb * sn[4 + e] : pb * sn[4 + e] + b * cs[4 + e];
                        }
                    }
                    u32x4 w; w.x = cvt_pk_bf16(v0[0], v0[1]); w.y = cvt_pk_bf16(v0[2], v0[3]); w.z = cvt_pk_bf16(v1[0], v1[1]); w.w = cvt_pk_bf16(v1[2], v1[3]);
                    *(u32x4*)(rowp + bj * HALF) = w;
                    if (cdst) { float* cp = cdst + (size_t)row * kw + ccol + bj * HALF; *(f32x4*)cp = v0; *(f32x4*)(cp + 4) = v1; }
                } }
    }
};

template <class Epi, class Sched, bool ALIGN_EPI = false, bool SP2 = false>
__device__ __forceinline__ void gemm_phase(PG8_LAS unsigned char* lds, const Gemm g, const Sched& S, const Epi& E) {
    int tid_raw = threadIdx.x; asm volatile("" : "+v"(tid_raw));
    const int tid = tid_raw, wid = __builtin_amdgcn_readfirstlane(tid >> 6), lane = tid & 63, wr = wid >> 2, wc = wid & 3, fr = lane & 15, fq = lane >> 4;
    const int K = g.K, nt = K / BK;
    unsigned voffA[2], voffB[2];
#pragma unroll
    for (int i = 0; i < 2; ++i) { int R, C; stage_rc(tid * 16 + i * 8192, R, C); const int Rb = Epi::PERM ? ((R & ~31) + perm32(R & 31)) : R;
        voffA[i] = (unsigned)(R * K + C) * 2u; voffB[i] = (unsigned)(Rb * K + C) * 2u; }
    const size_t kstep = (size_t)(BK * 2);
    const size_t hstep = (size_t)HALF * K * 2;
    const size_t tstep = 2 * hstep;
    const unsigned ldsw = (unsigned)wid * 1024u;
    const int aoff = lds_byte(wr * 64 + fr, fq * 8), boff = lds_byte(wc * 32 + fr, fq * 8);
#define PG8_SA(b, h) (((b) * 2 + (h)) * HTB)
#define PG8_SB(b, h) ((4 + (b) * 2 + (h)) * HTB)
#define PG8_STAGE(bufoff, gbase, voff) do { _Pragma("unroll") for (int _i = 0; _i < 2; ++_i) \
        __builtin_amdgcn_global_load_lds((const unsigned*)((const char*)(gbase) + (voff)[_i]), (PG8_LAS unsigned*)(lds + (bufoff) + ldsw + _i * 8192), 16, 0, 0); } while (0)
#define PG8_LDA(dst, b, h) do { _Pragma("unroll") for (int m = 0; m < 4; ++m) _Pragma("unroll") for (int k = 0; k < 2; ++k) dst[m][k] = *(const PG8_LAS bf16x8*)(lds + PG8_SA(b, h) + aoff + m * 2048 + k * 1024); } while (0)
#define PG8_LDB(dst, b, h) do { _Pragma("unroll") for (int n = 0; n < 2; ++n) _Pragma("unroll") for (int k = 0; k < 2; ++k) dst[n][k] = *(const PG8_LAS bf16x8*)(lds + PG8_SB(b, h) + boff + n * 2048 + k * 1024); } while (0)
#define PG8_MMA(ai, bj, At, Bt) do { __builtin_amdgcn_s_setprio(1); _Pragma("unroll") for (int m = 0; m < 4; ++m) _Pragma("unroll") for (int n = 0; n < 2; ++n) _Pragma("unroll") for (int k = 0; k < 2; ++k) \
        acc[ai][bj][m][n] = __builtin_amdgcn_mfma_f32_16x16x32_bf16(Bt[n][k], At[m][k], acc[ai][bj][m][n], 0, 0, 0); __builtin_amdgcn_s_setprio(0); } while (0)
#define PG8_WAIT_V(n) asm volatile("s_waitcnt vmcnt(" #n ")" ::: "memory")
#define PG8_WAIT_L(n) asm volatile("s_waitcnt lgkmcnt(" #n ")" ::: "memory")
#define PG8_BAR __builtin_amdgcn_s_barrier()
#define PG8_SCHED __builtin_amdgcn_sched_barrier(0)
    Unit cur, nxt; int ui = 0;
    if (!S.next(0, cur)) return;
    f32x4 acc[2][2][4][2];
#pragma unroll
    for (int a = 0; a < 2; ++a)
#pragma unroll
        for (int b = 0; b < 2; ++b)
#pragma unroll
            for (int m = 0; m < 4; ++m)
#pragma unroll
                for (int n = 0; n < 2; ++n) acc[a][b][m][n] = (f32x4){0.f, 0.f, 0.f, 0.f};
    bf16x8 At[4][2], B0[2][2], B1[2][2];
    const char* cA = (const char*)g.A + (size_t)cur.pm * tstep; const char* cB = (const char*)g.Bt + (size_t)cur.pn * tstep;
    S.a_ready(cur);
    if constexpr (SP2) {
        PG8_STAGE(PG8_SB(0, 0), cB, voffB); PG8_STAGE(PG8_SB(0, 1), cB + hstep, voffB); PG8_STAGE(PG8_SA(0, 0), cA, voffA); PG8_STAGE(PG8_SA(0, 1), cA + hstep, voffA);
        if (wr == 1) PG8_BAR;
        PG8_WAIT_V(2); PG8_BAR;
        PG8_STAGE(PG8_SB(1, 0), cB + kstep, voffB); PG8_STAGE(PG8_SA(1, 0), cA + kstep, voffA); PG8_STAGE(PG8_SB(1, 1), cB + hstep + kstep, voffB);
        PG8_WAIT_V(6); PG8_BAR;
    } else {
        PG8_STAGE(PG8_SB(0, 0), cB, voffB); PG8_STAGE(PG8_SA(0, 0), cA, voffA); PG8_STAGE(PG8_SB(0, 1), cB + hstep, voffB); PG8_STAGE(PG8_SA(0, 1), cA + hstep, voffA);
        if (wr == 1) PG8_BAR;
        PG8_WAIT_V(4); PG8_BAR;
        PG8_STAGE(PG8_SB(1, 0), cB + kstep, voffB); PG8_STAGE(PG8_SA(1, 0), cA + kstep, voffA); PG8_STAGE(PG8_SB(1, 1), cB + hstep + kstep, voffB);
        PG8_WAIT_V(6); PG8_BAR;
    }
    for (;;) {
        const bool has_next = S.next(ui + 1, nxt);
        const char* nA = has_next ? (const char*)g.A + (size_t)nxt.pm * tstep : cA; const char* nB = has_next ? (const char*)g.Bt + (size_t)nxt.pn * tstep : cB;
        for (int t = 0; t < nt; t += 2) {
            const bool last = (t == nt - 2);
            const char* a1 = cA + (size_t)(t + 1) * kstep;
            const char* a2 = last ? nA : cA + (size_t)(t + 2) * kstep; const char* b2 = last ? nB : cB + (size_t)(t + 2) * kstep;
            const char* a3 = a2 + kstep; const char* b3 = b2 + kstep;
            if (last && has_next) S.a_ready(nxt);
            if constexpr (SP2) {
            PG8_LDB(B0, 0, 0); PG8_LDB(B1, 0, 1); PG8_SCHED; PG8_LDA(At, 0, 0); PG8_STAGE(PG8_SA(1, 1), a1 + hstep, voffA);
            PG8_WAIT_V(8); PG8_WAIT_L(0); PG8_BAR; PG8_MMA(0, 0, At, B0); PG8_MMA(0, 1, At, B1); PG8_BAR; PG8_SCHED;
            PG8_LDA(At, 0, 1); PG8_STAGE(PG8_SB(0, 0), b2, voffB); PG8_STAGE(PG8_SB(0, 1), b2 + hstep, voffB); PG8_STAGE(PG8_SA(0, 0), a2, voffA);
            PG8_WAIT_V(8); PG8_WAIT_L(0); PG8_BAR; PG8_MMA(1, 0, At, B0); PG8_MMA(1, 1, At, B1); PG8_BAR; PG8_SCHED;
            PG8_LDB(B0, 1, 0); PG8_LDB(B1, 1, 1); PG8_SCHED; PG8_LDA(At, 1, 0); PG8_STAGE(PG8_SA(0, 1), a2 + hstep, voffA);
            PG8_WAIT_V(8); PG8_WAIT_L(0); PG8_BAR; PG8_MMA(0, 0, At, B0); PG8_MMA(0, 1, At, B1); PG8_BAR; PG8_SCHED;
            PG8_LDA(At, 1, 1); PG8_STAGE(PG8_SB(1, 0), b3, voffB); PG8_STAGE(PG8_SB(1, 1), b3 + hstep, voffB); PG8_STAGE(PG8_SA(1, 0), a3, voffA);
            PG8_WAIT_V(8); PG8_WAIT_L(0); PG8_BAR; PG8_MMA(1, 0, At, B0); PG8_MMA(1, 1, At, B1); PG8_BAR; PG8_SCHED;
            } else {
            PG8_LDB(B0, 0, 0); PG8_SCHED; PG8_LDA(At, 0, 0); PG8_STAGE(PG8_SA(1, 1), a1 + hstep, voffA);
            PG8_WAIT_L(8); PG8_BAR; PG8_WAIT_L(0); PG8_MMA(0, 0, At, B0); PG8_BAR; PG8_SCHED;
            PG8_LDB(B1, 0, 1); PG8_STAGE(PG8_SB(0, 0), b2, voffB);
            PG8_BAR; PG8_WAIT_L(0); PG8_MMA(0, 1, At, B1); PG8_BAR;
            PG8_LDA(At, 0, 1); PG8_STAGE(PG8_SA(0, 0), a2, voffA);
            PG8_BAR; PG8_WAIT_L(0); PG8_MMA(1, 0, At, B0); PG8_BAR; PG8_SCHED;
            PG8_STAGE(PG8_SB(0, 1), b2 + hstep, voffB);
            PG8_WAIT_V(6); PG8_BAR; PG8_MMA(1, 1, At, B1); PG8_BAR;
            PG8_LDB(B0, 1, 0); PG8_SCHED; PG8_LDA(At, 1, 0); PG8_STAGE(PG8_SA(0, 1), a2 + hstep, voffA);
            PG8_WAIT_L(8); PG8_BAR; PG8_WAIT_L(0); PG8_MMA(0, 0, At, B0); PG8_BAR; PG8_SCHED;
            PG8_LDB(B1, 1, 1); PG8_STAGE(PG8_SB(1, 0), b3, voffB);
            PG8_BAR; PG8_WAIT_L(0); PG8_MMA(0, 1, At, B1); PG8_BAR;
            PG8_LDA(At, 1, 1); PG8_STAGE(PG8_SA(1, 0), a3, voffA);
            PG8_BAR; PG8_WAIT_L(0); PG8_MMA(1, 0, At, B0); PG8_BAR; PG8_SCHED;
            PG8_STAGE(PG8_SB(1, 1), b3 + hstep, voffB);
            PG8_WAIT_V(6); PG8_BAR; PG8_MMA(1, 1, At, B1); PG8_BAR;
            }
        }
        if constexpr (ALIGN_EPI) { if (wr == 0) PG8_BAR; }
        if constexpr (!Epi::AFTER_DRAIN) { E(acc, cur, wr, wc, fr, fq); S.done(cur); }
        if (!has_next) break;
#pragma unroll
        for (int a = 0; a < 2; ++a)
#pragma unroll
            for (int b = 0; b < 2; ++b)
#pragma unroll
                for (int m = 0; m < 4; ++m)
#pragma unroll
                    for (int n = 0; n < 2; ++n) acc[a][b][m][n] = (f32x4){0.f, 0.f, 0.f, 0.f};
        cur = nxt; cA = nA; cB = nB; ++ui;
        if constexpr (ALIGN_EPI) { if (wr == 1) PG8_BAR; }
    }
    PG8_WAIT_V(0);
    if constexpr (!ALIGN_EPI) { if (wr == 0) PG8_BAR; }
    PG8_BAR;
    if constexpr (Epi::AFTER_DRAIN) { E.fused(acc, cur, wr, wc, fr, fq, lds, wid, lane); S.done(cur); }
#undef PG8_SA
#undef PG8_SB
#undef PG8_STAGE
#undef PG8_LDA
#undef PG8_LDB
#undef PG8_MMA
#undef PG8_WAIT_V
#undef PG8_WAIT_L
#undef PG8_BAR
#undef PG8_SCHED
}
}

constexpr int NWAVES = 8, NTHR = 512;
constexpr int DM = 2048, NTOK = 8192, NCTX = 4096, DFF = 8192, NLAYER = 4, NMODC = 12288;
constexpr float RMS_EPS = 1e-6f;
constexpr float LOG2E = 1.4426950408889634f;

constexpr size_t MiB = 1u << 20;
constexpr size_t WS_CTL = 0, CTL_ZERO_BYTES = 1 * MiB;
constexpr size_t WS_ROPE = 1 * MiB;
constexpr size_t WS_MOD = 2 * MiB;
constexpr size_t WS_MODP = 4 * MiB;
constexpr size_t WS_GATES = 12 * MiB;
constexpr size_t WS_W = 16 * MiB;
constexpr size_t W_AIN = WS_W, W_AOUT = W_AIN + 24 * MiB, W_BIN = W_AOUT + 8 * MiB, W_BOUT = W_BIN + 24 * MiB;
constexpr size_t W_CIN = W_BOUT + 8 * MiB, W_COUT = W_CIN + 24 * MiB, W_DIN = W_COUT + 8 * MiB, W_DOUT = W_DIN + 12 * MiB;
constexpr size_t W_FF1 = W_DOUT + 8 * MiB, W_FF2 = W_FF1 + 128 * MiB;
constexpr size_t WS_H = W_FF2 + 128 * MiB;
constexpr size_t WS_QKV = WS_H + 32 * MiB;
constexpr size_t WS_O = WS_QKV + 96 * MiB;
constexpr size_t WS_Y = WS_O + 32 * MiB;
constexpr size_t WS_U = WS_Y + 64 * MiB;
constexpr size_t WS_CAK = WS_U + 128 * MiB, WS_CAV = WS_CAK + 8 * MiB, WS_CCK = WS_CAV + 8 * MiB, WS_CCV = WS_CCK + 8 * MiB;
constexpr size_t WS_CDK = WS_CCV + 8 * MiB, WS_CDV = WS_CDK + 2 * MiB, WS_SC = WS_CDV + 2 * MiB;
constexpr size_t WS_END = WS_SC + 4 * MiB;
constexpr int CW_BAR = 4096;

constexpr size_t O_YP = 0, O_AK = 16777216, O_AV = 25165824, O_BC = 33554432, O_BN = 41943040, O_BM = 41975808, O_CK = 41976064, O_CV = 50364672, O_DK = 58753280, O_DV = 60850432, O_END = 62947584;

constexpr int LDS_PHASE_BYTES = 155648;
constexpr int MISC_OFF = LDS_PHASE_BYTES;
constexpr int LDS_BYTES = LDS_PHASE_BYTES + 256;

#define LAS __attribute__((address_space(3)))
#define DI __device__ __forceinline__
typedef unsigned short bf16;
typedef short bf16x8 __attribute__((ext_vector_type(8)));
typedef short s16x4 __attribute__((ext_vector_type(4)));
typedef float f32x16 __attribute__((ext_vector_type(16)));
typedef float f32x4 __attribute__((ext_vector_type(4)));
typedef float f32x2 __attribute__((ext_vector_type(2)));
typedef unsigned u32x4 __attribute__((ext_vector_type(4)));
typedef unsigned u32x2 __attribute__((ext_vector_type(2)));
typedef __bf16 bf16x2_t __attribute__((ext_vector_type(2)));
typedef LAS char* ldsp;

DI unsigned pk2(float lo, float hi) { f32x2 v = {lo, hi}; bf16x2_t b = __builtin_convertvector(v, bf16x2_t); return __builtin_bit_cast(unsigned, b); }
DI float bf2f(unsigned short v) { return __uint_as_float(((unsigned)v) << 16); }
DI float bflo(unsigned w) { return __uint_as_float(w << 16); }
DI float bfhi(unsigned w) { return __uint_as_float(w & 0xffff0000u); }
DI float ex2(float x) { return __builtin_amdgcn_exp2f(x); }
DI float wave_sum(float v) {
#pragma unroll
    for (int o = 1; o < 64; o <<= 1) v += __shfl_xor(v, o);
    return v;
}
DI float hmax(float x) { auto rr = __builtin_amdgcn_permlane32_swap(__float_as_uint(x), __float_as_uint(x), false, false); return fmaxf(__uint_as_float(rr[0]), __uint_as_float(rr[1])); }
DI float hsum(float x) { auto rr = __builtin_amdgcn_permlane32_swap(__float_as_uint(x), __float_as_uint(x), false, false); return __uint_as_float(rr[0]) + __uint_as_float(rr[1]); }
DI int crow(int r, int hi) { return (r & 3) + 8 * (r >> 2) + 4 * hi; }

#define XB_TMO      128
#define XB_XCNT(j)  (256  + 64 * (j))
#define XB_XSUB(j)  (1280 + 64 * (j))
#define XB_XGEN(j)  (2304 + 64 * (j))
#define XB_TOP      3328
#define XB_TOPGEN   3392
#define XCD_BAR_WORDS 3456
#define XB_SPIN_CAP (1u << 18)
__device__ __forceinline__ unsigned xb_ld(unsigned* p)              { return __hip_atomic_load(p, __ATOMIC_RELAXED, __HIP_MEMORY_SCOPE_AGENT); }
__device__ __forceinline__ unsigned xb_add(unsigned* p, unsigned v) { return __hip_atomic_fetch_add(p, v, __ATOMIC_RELAXED, __HIP_MEMORY_SCOPE_AGENT); }
__device__ __forceinline__ unsigned xb_xcc_id() { return (unsigned)__builtin_amdgcn_s_getreg((3 << 11) | 20) & 0xFu; }
#define XB_SPIN(cond, bar) do { unsigned _sp = 0; while (cond) { __builtin_amdgcn_s_sleep(1); \
    if ((++_sp & 255u) == 0u) { if (xb_ld(&(bar)[XB_TMO])) break; if (_sp > XB_SPIN_CAP) { atomicAdd(&(bar)[XB_TMO], 1u); break; } } } } while (0)
struct XcdBarrier { unsigned* bar; unsigned x; volatile LAS unsigned* st; };
__device__ __forceinline__ XcdBarrier xcd_barrier_post(unsigned* bar, volatile LAS unsigned* st) {
    XcdBarrier b; b.bar = bar; b.x = xb_xcc_id(); b.st = st;
    if (threadIdx.x == 0) (void)xb_add(&bar[XB_XCNT(b.x)], 1u);
    return b;
}
__device__ __forceinline__ void xcd_barrier_complete(unsigned* bar, unsigned x, unsigned& nloc, unsigned& nx) {
    const unsigned G = gridDim.x * gridDim.y * gridDim.z;
    unsigned sum, cnt, mine, sp = 0u;
    for (;;) {
        sum = 0u; cnt = 0u; mine = 0u;
#pragma unroll
        for (unsigned j = 0; j < 16; ++j) { const unsigned c = xb_ld(&bar[XB_XCNT(j)]); sum += c; cnt += (c > 0u) ? 1u : 0u; mine = (j == x) ? c : mine; }
        if (sum == G) break;
        __builtin_amdgcn_s_sleep(1);
        if ((++sp & 255u) == 0u) { if (xb_ld(&bar[XB_TMO])) break; if (sp > XB_SPIN_CAP) { atomicAdd(&bar[XB_TMO], 1u); break; } }
    }
    nloc = mine > 0u ? mine : 1u; nx = cnt > 0u ? cnt : 1u;
}
__device__ __forceinline__ void xcd_barrier(const XcdBarrier& b) {
    asm volatile("s_waitcnt vmcnt(0)" ::: "memory");
    __syncthreads();
    if (threadIdx.x == 0) {
        unsigned* bar = b.bar;
        __builtin_amdgcn_s_waitcnt(0);
        unsigned nloc = b.st[0], nx = b.st[1];
        if (nloc == 0u) { xcd_barrier_complete(bar, b.x, nloc, nx); b.st[0] = nloc; b.st[1] = nx; }
        const unsigned old = xb_add(&bar[XB_XSUB(b.x)], 1u);
        const unsigned gen = old / nloc;
        if (old + 1u == (gen + 1u) * nloc) {
            __builtin_amdgcn_fence(__ATOMIC_RELEASE, "agent");
            asm volatile("s_waitcnt vmcnt(0)" ::: "memory");
            const unsigned og = xb_add(&bar[XB_TOP], 1u);
            const unsigned tg = og / nx;
            if (og + 1u == (tg + 1u) * nx) xb_add(&bar[XB_TOPGEN], 1u);
            else XB_SPIN(xb_ld(&bar[XB_TOPGEN]) == tg, bar);
            __builtin_amdgcn_fence(__ATOMIC_ACQUIRE, "agent");
            xb_add(&bar[XB_XGEN(b.x)], 1u);
            asm volatile("s_waitcnt vmcnt(0)" ::: "memory");
        } else {
            XB_SPIN(xb_ld(&bar[XB_XGEN(b.x)]) == gen, bar);
            __builtin_amdgcn_fence(__ATOMIC_ACQUIRE, "agent");
            asm volatile("s_waitcnt vmcnt(0)" ::: "memory");
        }
    }
    __syncthreads();
}

struct Args { const float* in[32]; float* out; unsigned char* ws; int ph_lo, ph_hi; };

DI void transpose_item(const float* W, int K, int N, int ld, bf16* WT, LAS float* scr, int item, int lane) {
    const int nblk = N / 32, kb = item / nblk, nb = item % nblk, k0 = 64 * kb, n0 = 32 * nb;
#pragma unroll 8
    for (int i = 0; i < 32; ++i) { const int kk = 2 * i + (lane >> 5); scr[kk * 33 + (lane & 31)] = W[(size_t)(k0 + kk) * ld + n0 + (lane & 31)]; }
    asm volatile("s_waitcnt lgkmcnt(0)" ::: "memory");
    const int c = lane & 7;
#pragma unroll
    for (int j = 0; j < 4; ++j) { const int n = (lane >> 3) + 8 * j; const LAS float* s = scr + (8 * c) * 33 + n;
        u32x4 o; o.x = pk2(s[0 * 33], s[1 * 33]); o.y = pk2(s[2 * 33], s[3 * 33]); o.z = pk2(s[4 * 33], s[5 * 33]); o.w = pk2(s[6 * 33], s[7 * 33]);
        *(u32x4*)(WT + (size_t)(n0 + n) * K + k0 + 8 * c) = o; }
    asm volatile("s_waitcnt lgkmcnt(0)" ::: "memory");
}
DI void cvt_flat(const float* src, bf16* dst, size_t n8, size_t gtid, size_t nthr) {
    for (size_t i = gtid; i < n8; i += nthr) { const f32x4 a = *(const f32x4*)(src + i * 8), b = *(const f32x4*)(src + i * 8 + 4);
        u32x4 o; o.x = pk2(a[0], a[1]); o.y = pk2(a[2], a[3]); o.z = pk2(b[0], b[1]); o.w = pk2(b[2], b[3]); *(u32x4*)(dst + i * 8) = o; }
}
DI float silu(float x) { return x / (1.f + __expf(-x)); }

DI void p0a_prologue(const Args& A, ldsp lds, int G, int bid, int tid) {
    const int lane = tid & 63, wave = tid >> 6;
    unsigned char* ws = A.ws;
    const int gw = bid * NWAVES + wave, NGW = G * NWAVES;
    LAS float* scr = (LAS float*)(lds + wave * 16384);
    constexpr int I_IN = (DM / 64) * (6144 / 32), I_OUT = (DM / 64) * (DM / 32), I_DIN = (DM / 64) * (3072 / 32), I_F1 = (DM / 64) * (DFF / 32), I_F2 = (DFF / 64) * (DM / 32);
    constexpr int NITEMS = 3 * I_IN + 4 * I_OUT + I_DIN + 4 * I_F1 + 4 * I_F2;
    for (int it = gw; it < NITEMS; it += NGW) {
        int r = it;
        if (r < I_IN) { transpose_item(A.in[18], DM, 6144, 6144, (bf16*)(ws + W_AIN), scr, r, lane); continue; } r -= I_IN;
        if (r < I_OUT) { transpose_item(A.in[19], DM, DM, DM, (bf16*)(ws + W_AOUT), scr, r, lane); continue; } r -= I_OUT;
        if (r < I_IN) { transpose_item(A.in[22], DM, 6144, 6176, (bf16*)(ws + W_BIN), scr, r, lane); continue; } r -= I_IN;
        if (r < I_OUT) { transpose_item(A.in[24], DM, DM, DM, (bf16*)(ws + W_BOUT), scr, r, lane); continue; } r -= I_OUT;
        if (r < I_IN) { transpose_item(A.in[26], DM, 6144, 6144, (bf16*)(ws + W_CIN), scr, r, lane); continue; } r -= I_IN;
        if (r < I_OUT) { transpose_item(A.in[27], DM, DM, DM, (bf16*)(ws + W_COUT), scr, r, lane); continue; } r -= I_OUT;
        if (r < I_DIN) { transpose_item(A.in[29], DM, 3072, 3072, (bf16*)(ws + W_DIN), scr, r, lane); continue; } r -= I_DIN;
        if (r < I_OUT) { transpose_item(A.in[30], DM, DM, DM, (bf16*)(ws + W_DOUT), scr, r, lane); continue; } r -= I_OUT;
        if (r < 4 * I_F1) { const int L = r / I_F1; r -= L * I_F1;
            transpose_item(A.in[16] + (size_t)L * DM * DFF, DM, DFF, DFF, (bf16*)(ws + W_FF1) + (size_t)L * DM * DFF, scr, r, lane); continue; } r -= 4 * I_F1;
        { const int L = r / I_F2; r -= L * I_F2;
            transpose_item(A.in[17] + (size_t)L * DM * DFF, DFF, DM, DM, (bf16*)(ws + W_FF2) + (size_t)L * DM * DFF, scr, r, lane); }
    }
    const size_t gtid = (size_t)bid * NTHR + tid, nthr = (size_t)G * NTHR;
    cvt_flat(A.in[2], (bf16*)(ws + WS_CAK), (size_t)4 * 512 * 2048 / 8, gtid, nthr);
    cvt_flat(A.in[3], (bf16*)(ws + WS_CAV), (size_t)4 * 512 * 2048 / 8, gtid, nthr);
    cvt_flat(A.in[7], (bf16*)(ws + WS_CCK), (size_t)4 * 512 * 2048 / 8, gtid, nthr);
    cvt_flat(A.in[8], (bf16*)(ws + WS_CCV), (size_t)4 * 512 * 2048 / 8, gtid, nthr);
    cvt_flat(A.in[9], (bf16*)(ws + WS_CDK), (size_t)4 * 512 * 512 / 8, gtid, nthr);
    cvt_flat(A.in[10], (bf16*)(ws + WS_CDV), (size_t)4 * 512 * 512 / 8, gtid, nthr);
    cvt_flat(A.in[4], (bf16*)(ws + WS_SC), (size_t)4 * 2 * 8 * 256 * 128 / 8, gtid, nthr);
    if (gtid < 1024) {
        const int pos = (int)gtid >> 4, i = (int)gtid & 15;
        double inv = 1.0; for (int k = 0; k < i; ++k) inv *= 0.5623413251903491;
        const double rev = (double)pos * inv * 0.15915494309189535;
        const double fr = rev - floor(rev);
        float* rt = (float*)(ws + WS_ROPE);
        rt[gtid * 2] = __builtin_amdgcn_cosf((float)fr); rt[gtid * 2 + 1] = __builtin_amdgcn_sinf((float)fr);
    }
    float* modp = (float*)(ws + WS_MODP);
    for (int un = gw; un < 4 * 48 * 8; un += NGW) {
        const int L = un / 384, rem = un % 384, cb = rem >> 3, ks = rem & 7;
        const float* wm = A.in[13] + ((size_t)L * DM + ks * 256) * NMODC + cb * 256 + lane * 4;
        f32x4 acc[5];
#pragma unroll
        for (int c = 0; c < 5; ++c) acc[c] = (f32x4){0.f, 0.f, 0.f, 0.f};
#pragma unroll 4
        for (int k = 0; k < 256; ++k) {
            const f32x4 w = *(const f32x4*)(wm + (size_t)k * NMODC);
            const int kk = ks * 256 + k;
            const float s0 = silu(A.in[12][kk]);
            acc[0] += w * s0;
#pragma unroll
            for (int c = 1; c < 5; ++c) { const float s = silu(A.in[11][(c - 1) * DM + kk]); acc[c] += w * s; }
        }
#pragma unroll
        for (int c = 0; c < 5; ++c) *(f32x4*)(modp + ((size_t)(L * 8 + ks) * 5 + c) * NMODC + cb * 256 + lane * 4) = acc[c];
    }
}
DI void p0b_modreduce(const Args& A, int G, int bid, int tid) {
    const float* modp = (const float*)(A.ws + WS_MODP); float* mod = (float*)(A.ws + WS_MOD);
    for (int i = bid * NTHR + tid; i < 4 * 5 * NMODC; i += G * NTHR) {
        const int L = i / (5 * NMODC), rem = i % (5 * NMODC), c = rem / NMODC, col = rem % NMODC;
        float s = A.in[14][L * NMODC + col];
#pragma unroll
        for (int ks = 0; ks < 8; ++ks) s += modp[((size_t)(L * 8 + ks) * 5 + c) * NMODC + col];
        mod[i] = s;
    }
}

struct RowP {
    const float* Y;
    int mod_gate;
    int Lg;
    int gpost;
    int has_next;
    int Ln;
    int gpre;
    int mod_shift;
    int do_gates;
};
DI void row_phase(const Args& A, const RowP& P, ldsp lds, int G, int bid, int tid) {
    const int lane = tid & 63, wave = tid >> 6;
    const int gw = bid * NWAVES + wave, NGW = G * NWAVES;
    float* X = A.out; bf16* H = (bf16*)(A.ws + WS_H);
    const float* mod = (const float*)(A.ws + WS_MOD); const float* gn = A.in[15];
    for (int r = gw; r < NTOK; r += NGW) {
        const int cond = r < NCTX ? 0 : 1 + ((r - NCTX) >> 10);
        f32x4 x[8];
        if (P.Y == nullptr) {
            const float* src = r < NCTX ? A.in[0] + (size_t)r * DM : A.in[1] + (size_t)(r - NCTX) * DM;
#pragma unroll
            for (int j = 0; j < 8; ++j) x[j] = *(const f32x4*)(src + 4 * lane + 256 * j);
        } else {
            f32x4 y[8]; float ss = 0.f;
#pragma unroll
            for (int j = 0; j < 8; ++j) { y[j] = *(const f32x4*)(P.Y + (size_t)r * DM + 4 * lane + 256 * j); ss += (y[j][0] * y[j][0] + y[j][1] * y[j][1]) + (y[j][2] * y[j][2] + y[j][3] * y[j][3]); }
            const float rs = 1.0f / sqrtf(wave_sum(ss) * (1.f / DM) + RMS_EPS);
            const float* gate = mod + ((size_t)(P.Lg * 5 + cond) * 6 + P.mod_gate) * DM; const float* gp = gn + (size_t)P.gpost * DM;
#pragma unroll
            for (int j = 0; j < 8; ++j) { const f32x4 xv = *(const f32x4*)(X + (size_t)r * DM + 4 * lane + 256 * j);
                const f32x4 gt = *(const f32x4*)(gate + 4 * lane + 256 * j), gg = *(const f32x4*)(gp + 4 * lane + 256 * j);
                x[j] = xv + gt * (y[j] * rs * gg); }
        }
#pragma unroll
        for (int j = 0; j < 8; ++j) *(f32x4*)(X + (size_t)r * DM + 4 * lane + 256 * j) = x[j];
        if (P.has_next) {
            float ss = 0.f;
#pragma unroll
            for (int j = 0; j < 8; ++j) ss += (x[j][0] * x[j][0] + x[j][1] * x[j][1]) + (x[j][2] * x[j][2] + x[j][3] * x[j][3]);
            const float rs = 1.0f / sqrtf(wave_sum(ss) * (1.f / DM) + RMS_EPS);
            const float* sh = mod + ((size_t)(P.Ln * 5 + cond) * 6 + P.mod_shift) * DM; const float* sc = sh + DM; const float* gp = gn + (size_t)P.gpre * DM;
#pragma unroll
            for (int j = 0; j < 8; ++j) { const f32x4 gg = *(const f32x4*)(gp + 4 * lane + 256 * j), s1 = *(const f32x4*)(sc + 4 * lane + 256 * j), s0 = *(const f32x4*)(sh + 4 * lane + 256 * j);
                x[j] = (x[j] * rs * gg) * (1.0f + s1) + s0;
                u32x2 o; o.x = pk2(x[j][0], x[j][1]); o.y = pk2(x[j][2], x[j][3]);
                *(u32x2*)(H + (size_t)r * DM + 4 * lane + 256 * j) = o; }
            if (P.do_gates) {
                LAS float* hrow = (LAS float*)(lds + wave * 8192);
#pragma unroll
                for (int j = 0; j < 8; ++j) *(LAS f32x4*)(hrow + 4 * lane + 256 * j) = x[j];
                asm volatile("s_waitcnt lgkmcnt(0)" ::: "memory");
                const float* Wg = A.in[22] + 6144;
                float acc[32];
#pragma unroll
                for (int g = 0; g < 32; ++g) acc[g] = 0.f;
#pragma unroll 2
                for (int i = 0; i < 32; ++i) { const int c = lane + 64 * i; const float hv = hrow[c]; const float* wr = Wg + (size_t)c * 6176;
#pragma unroll
                    for (int q = 0; q < 8; ++q) { const f32x4 w = *(const f32x4*)(wr + 4 * q);
                        acc[4 * q] += hv * w[0]; acc[4 * q + 1] += hv * w[1]; acc[4 * q + 2] += hv * w[2]; acc[4 * q + 3] += hv * w[3]; } }
                float mine = 0.f;
#pragma unroll
                for (int g = 0; g < 32; ++g) { const float sg = wave_sum(acc[g]); mine = (lane == g) ? sg : mine; }
                if (lane < 32) ((float*)(A.ws + WS_GATES))[(size_t)r * 32 + lane] = mine + A.in[23][lane];
                asm volatile("s_waitcnt lgkmcnt(0)" ::: "memory");
            }
        }
    }
}

typedef short v4i16_t __attribute__((ext_vector_type(4)));
DI s16x4 tr_read(ldsp p) { return __builtin_bit_cast(s16x4, __builtin_amdgcn_ds_read_tr16_b64_v4i16((LAS v4i16_t*)p)); }
#define MFMA32(a, b, c) __builtin_amdgcn_mfma_f32_32x32x16_bf16((a), (b), (c), 0, 0, 0)

template <int NS> DI void qk_tile(f32x16& s, ldsp kaddr, const bf16x8 (&qr)[NS]) {
#pragma unroll
    for (int i = 0; i < 16; ++i) s[i] = 0.f;
#pragma unroll
    for (int d0 = 0; d0 < NS; ++d0) { const bf16x8 a = *(const LAS bf16x8*)(kaddr + 32 * d0); s = MFMA32(a, qr[d0], s); }
}
template <int NS> DI void qk_tile_lq(f32x16& s, ldsp kaddr, ldsp qaddr) {
#pragma unroll
    for (int i = 0; i < 16; ++i) s[i] = 0.f;
#pragma unroll
    for (int d0 = 0; d0 < NS; ++d0) { const bf16x8 a = *(const LAS bf16x8*)(kaddr + 32 * d0); const bf16x8 b = *(const LAS bf16x8*)(qaddr + 32 * d0); s = MFMA32(a, b, s); }
}
template <int S> DI bf16x8 pack8(const f32x16& p) {
    u32x4 w; w.x = pk2(p[8 * S + 0], p[8 * S + 1]); w.y = pk2(p[8 * S + 2], p[8 * S + 3]); w.z = pk2(p[8 * S + 4], p[8 * S + 5]); w.w = pk2(p[8 * S + 6], p[8 * S + 7]);
    return __builtin_bit_cast(bf16x8, w);
}
template <int ND> DI void pv_tile(f32x16 (&o)[ND], ldsp vaddr, int pvb, bf16x8 p0, bf16x8 p1) {
#pragma unroll
    for (int d0 = 0; d0 < ND; ++d0) {
        const s16x4 l0 = tr_read(vaddr + 64 * d0), h0 = tr_read(vaddr + 8 * pvb + 64 * d0);
        const s16x4 l1 = tr_read(vaddr + 16 * pvb + 64 * d0), h1 = tr_read(vaddr + 24 * pvb + 64 * d0);
        const bf16x8 a0 = {l0[0], l0[1], l0[2], l0[3], h0[0], h0[1], h0[2], h0[3]};
        const bf16x8 a1 = {l1[0], l1[1], l1[2], l1[3], h1[0], h1[1], h1[2], h1[3]};
        o[d0] = MFMA32(a0, p0, o[d0]);
        o[d0] = MFMA32(a1, p1, o[d0]);
    }
}
template <int NC> DI void stage_ld(bf16x8 (&r)[NC / 64], const bf16* src, size_t gs, int tid) {
#pragma unroll
    for (int i = 0; i < NC / 64; ++i) { const int idx = tid + NTHR * i, row = idx / (NC / 8), c8 = idx % (NC / 8); r[i] = *(const bf16x8*)(src + (size_t)row * gs + c8 * 8); }
}
template <int NC> DI void stage_st(const bf16x8 (&r)[NC / 64], ldsp dst, int pb, int tid) {
#pragma unroll
    for (int i = 0; i < NC / 64; ++i) { const int idx = tid + NTHR * i, row = idx / (NC / 8), c8 = idx % (NC / 8); *(LAS bf16x8*)(dst + row * pb + c8 * 16) = r[i]; }
}

template <int DQK, int KW, int DV, bool QLDS, class Pol>
DI void attn_loop(ldsp lds, const Pol& P, const bf16x8 (&qr)[QLDS ? 1 : DQK / 16], ldsp qa, f32x16 (&o)[DV / 32], float& m, float& l, int tid) {
    constexpr int PKB = KW * 2 + 16, PVB = DV * 2 + 16, KBYTES = 64 * PKB, VBYTES = 64 * PVB, BUF = KBYTES + VBYTES;
    const int lane = tid & 63, r32 = lane & 31, h2 = lane >> 5, i16 = lane & 15, tq = i16 >> 2, tp = i16 & 3, blk = (lane >> 4) & 1;
    const int koff = r32 * PKB + P.kcol * 2 + h2 * 16;
    const int voff = (4 * h2 + tq) * PVB + (16 * blk + 4 * tp) * 2;
    bf16x8 kst[KW / 64], vst[DV / 64];
    const int n = P.nchunks;
    { const bf16 *kp, *vp; size_t st; P.src(0, kp, vp, st); stage_ld<KW>(kst, kp, st, tid); stage_ld<DV>(vst, vp, st, tid); }
    for (int c = 0; c < n; ++c) {
        ldsp kb = lds + (c & 1) * BUF; ldsp vb = kb + KBYTES;
        stage_st<KW>(kst, kb, PKB, tid); stage_st<DV>(vst, vb, PVB, tid);
        __syncthreads();
        if (c + 1 < n) { const bf16 *kp, *vp; size_t st; P.src(c + 1, kp, vp, st); stage_ld<KW>(kst, kp, st, tid); stage_ld<DV>(vst, vp, st, tid); }
        if (P.active(c)) {
#pragma unroll
            for (int kt = 0; kt < 2; ++kt) {
                f32x16 s0;
                if constexpr (QLDS) qk_tile_lq<DQK / 16>(s0, kb + koff + 32 * kt * PKB, qa); else qk_tile<DQK / 16>(s0, kb + koff + 32 * kt * PKB, qr);
                P.fix(c, kt, s0);
                float mx = s0[0];
#pragma unroll
                for (int r = 1; r < 16; ++r) mx = fmaxf(mx, s0[r]);
                mx = hmax(mx);
                const float mn = fmaxf(m, mx), alpha = ex2(m - mn); m = mn;
                float ps = 0.f;
#pragma unroll
                for (int r = 0; r < 16; ++r) { s0[r] = ex2(s0[r] - mn); ps += s0[r]; }
                ps = hsum(ps);
                l = l * alpha + ps;
#pragma unroll
                for (int d0 = 0; d0 < DV / 32; ++d0)
#pragma unroll
                    for (int r = 0; r < 16; ++r) o[d0][r] *= alpha;
                pv_tile<DV / 32>(o, vb + voff + 32 * kt * PVB, PVB, pack8<0>(s0), pack8<1>(s0));
            }
        }
    }
    __syncthreads();
}
template <int ND> DI void store_ot(const f32x16 (&o)[ND], float inv, bf16* orow, int h2) {
#pragma unroll
    for (int d0 = 0; d0 < ND; ++d0)
#pragma unroll
        for (int g = 0; g < 4; ++g) { u32x2 w; w.x = pk2(o[d0][4 * g] * inv, o[d0][4 * g + 1] * inv); w.y = pk2(o[d0][4 * g + 2] * inv, o[d0][4 * g + 3] * inv);
            *(u32x2*)(orow + 32 * d0 + 8 * g + 4 * h2) = w; }
}

struct PolA {
    int nchunks, kcol; const bf16* QKV; const bf16* CK; const bf16* CV; int b, h, latent;
    DI void src(int c, const bf16*& kp, const bf16*& vp, size_t& st) const {
        if (latent && c < 8) { const size_t off = ((size_t)(b * 512 + 64 * c) * 16 + h) * 128; kp = CK + off; vp = CV + off; st = 2048; }
        else { const int row = latent ? NCTX + b * 1024 + 64 * (c - 8) : b * 256 + 64 * c; kp = QKV + (size_t)row * 6144 + 2048 + h * 128; vp = kp + 2048; st = 6144; }
    }
    DI bool active(int) const { return true; }
    DI void fix(int, int, f32x16& s) const {
#pragma unroll
        for (int r = 0; r < 16; ++r) s[r] *= 0.125f * LOG2E;
    }
};
DI void phaseA(const Args& A, ldsp lds, int G, int bid, int tid) {
    const int lane = tid & 63, wave = tid >> 6, r32 = lane & 31, h2 = lane >> 5, j = wave >> 2, wq = wave & 3;
    const bf16* QKV = (const bf16*)(A.ws + WS_QKV); bf16* O = (bf16*)(A.ws + WS_O);
    const float lam_init = 0.2f;
    LAS float* xb = (LAS float*)lds;
    for (int u = bid; u < 1024; u += G) {
        PolA P; P.QKV = QKV; P.CK = (const bf16*)(A.ws + WS_CAK); P.CV = (const bf16*)(A.ws + WS_CAV); P.kcol = 64 * j;
        int rowbase;
        if (u < 512) { P.latent = 0; P.b = u >> 5; P.h = (u >> 1) & 15; P.nchunks = 4; rowbase = P.b * 256 + (u & 1) * 128; }
        else { const int v = u - 512; P.latent = 1; P.b = v >> 7; P.h = (v >> 3) & 15; P.nchunks = 24; rowbase = NCTX + P.b * 1024 + (v & 7) * 128; }
        const int row = rowbase + 32 * wq + r32;
        bf16x8 qr[4];
#pragma unroll
        for (int d0 = 0; d0 < 4; ++d0) qr[d0] = *(const bf16x8*)(QKV + (size_t)row * 6144 + P.h * 128 + j * 64 + 16 * d0 + 8 * h2);
        f32x16 o[4];
#pragma unroll
        for (int d0 = 0; d0 < 4; ++d0)
#pragma unroll
            for (int r = 0; r < 16; ++r) o[d0][r] = 0.f;
        float m = -1e30f, l = 0.f;
        attn_loop<64, 128, 128, false, PolA>(lds, P, qr, lds, o, m, l, tid);
        const float inv = 1.0f / l;
        if (j == 1) {
#pragma unroll
            for (int d0 = 0; d0 < 4; ++d0)
#pragma unroll
                for (int r = 0; r < 16; ++r) xb[((wq * 4 + d0) * 16 + r) * 64 + lane] = o[d0][r] * inv;
        }
        __syncthreads();
        if (j == 0) {
            const float* lp = A.in[20];
            float d1 = 0.f, d2 = 0.f;
#pragma unroll 8
            for (int d = 0; d < 64; ++d) { d1 += lp[(0 * 16 + P.h) * 64 + d] * lp[(1 * 16 + P.h) * 64 + d]; d2 += lp[(2 * 16 + P.h) * 64 + d] * lp[(3 * 16 + P.h) * 64 + d]; }
            const float lam = __expf(d1) - __expf(d2) + lam_init;
            float ss = 0.f;
#pragma unroll
            for (int d0 = 0; d0 < 4; ++d0)
#pragma unroll
                for (int r = 0; r < 16; ++r) { const float v = o[d0][r] * inv - lam * xb[((wq * 4 + d0) * 16 + r) * 64 + lane]; o[d0][r] = v; ss += v * v; }
            ss = hsum(ss);
            const float rs = (1.0f / sqrtf(ss * (1.f / 128.f) + RMS_EPS)) * (1.0f - lam_init);
            const float* sub = A.in[21];
#pragma unroll
            for (int d0 = 0; d0 < 4; ++d0)
#pragma unroll
                for (int r = 0; r < 16; ++r) o[d0][r] *= sub[32 * d0 + crow(r, h2)];
            store_ot<4>(o, rs, O + (size_t)row * DM + P.h * 128, h2);
        }
        __syncthreads();
    }
}

struct PolC {
    int nchunks, kcol; const bf16* QKV; const bf16* CK; const bf16* CV; int b, h, latent;
    int nb, krlo, r, r0, qc, cstart; const LAS float* rpb;
    DI void src(int c, const bf16*& kp, const bf16*& vp, size_t& st) const {
        if (latent && c >= nb) { const size_t off = ((size_t)(b * 512 + 64 * (c - nb)) * 16 + h) * 128; kp = CK + off; vp = CV + off; st = 2048; }
        else { const int row = latent ? NCTX + b * 1024 + 64 * (krlo + c) : b * 256 + 64 * c; kp = QKV + (size_t)row * 6144 + 2048 + h * 128; vp = kp + 2048; st = 6144; }
    }
    DI bool active(int c) const { return !latent || c >= nb || (krlo + c >= r0 && krlo + c < r0 + 8); }
    DI void fix(int c, int kt, f32x16& s) const {
        const float sc = 0.08838834764831845f;
        if (latent && c < nb) {
            int h2 = (threadIdx.x >> 5) & 1; asm volatile("" : "+v"(h2));
            const int kr = krlo + c;
            int drow = kr - r + 7; drow = drow < 0 ? 0 : (drow > 14 ? 14 : drow);
#pragma unroll
            for (int rr = 0; rr < 16; ++rr) { const int kc = 32 * kt + crow(rr, h2); const bool ok = (kc >= cstart) && (kc < cstart + 16);
                int dc = kc - qc + 15; dc = dc < 0 ? 0 : (dc > 30 ? 30 : dc);
                const float bias = rpb[drow * 31 + dc];
                s[rr] = ok ? (s[rr] * sc + bias) * LOG2E : -INFINITY; }
        } else {
#pragma unroll
            for (int rr = 0; rr < 16; ++rr) s[rr] *= sc * LOG2E;
        }
    }
};
DI void phaseC(const Args& A, ldsp lds, int G, int bid, int tid) {
    const int lane = tid & 63, wave = __builtin_amdgcn_readfirstlane(tid >> 6), r32 = lane & 31, h2 = lane >> 5;
    const bf16* QKV = (const bf16*)(A.ws + WS_QKV); bf16* O = (bf16*)(A.ws + WS_O);
    LAS float* rpbL = (LAS float*)(lds + 2 * (64 * 272 + 64 * 272));
    const ldsp qt = lds + 2 * (64 * 272 + 64 * 272) + 2048;
    for (int u = bid; u < 512; u += G) {
        PolC P; P.QKV = QKV; P.CK = (const bf16*)(A.ws + WS_CCK); P.CV = (const bf16*)(A.ws + WS_CCV); P.kcol = 0; P.rpb = rpbL;
        int row;
        if (u < 256) { P.latent = 0; P.b = u >> 4; P.h = u & 15; P.nchunks = 4; row = P.b * 256 + 32 * wave + r32; P.nb = 0; P.krlo = 0; P.r = 0; P.r0 = 0; P.qc = 0; P.cstart = 0; }
        else { const int v = u - 256; P.latent = 1; P.b = v >> 6; P.h = (v >> 2) & 15; const int R4 = v & 3;
            const int rlo = 4 * R4, rhi = 4 * R4 + 3;
            const int r0lo = rlo - 4 < 0 ? 0 : (rlo - 4 > 8 ? 8 : rlo - 4), r0hi = rhi - 4 < 0 ? 0 : (rhi - 4 > 8 ? 8 : rhi - 4);
            P.krlo = r0lo; P.nb = r0hi + 8 - r0lo; P.nchunks = P.nb + 8;
            P.r = rlo + (wave >> 1); P.r0 = P.r - 4 < 0 ? 0 : (P.r - 4 > 8 ? 8 : P.r - 4);
            P.qc = 32 * (wave & 1) + r32; P.cstart = P.qc - 8 < 0 ? 0 : (P.qc - 8 > 48 ? 48 : P.qc - 8);
            row = NCTX + P.b * 1024 + P.r * 64 + P.qc;
            for (int i = tid; i < 15 * 31; i += NTHR) rpbL[i] = A.in[28][(size_t)P.h * 465 + i];
        }
        { const bf16* qsrc = QKV + (size_t)(row - 32 * wave - r32) * 6144 + P.h * 128;
#pragma unroll
          for (int hh = 0; hh < 4; ++hh) { bf16x8 qs[2]; stage_ld<128>(qs, qsrc + (size_t)64 * hh * 6144, 6144, tid); stage_st<128>(qs, qt + 64 * hh * 272, 272, tid); } }
        const ldsp qa = qt + (32 * wave + r32) * 272 + h2 * 16;
        bf16x8 qr[1];
        f32x16 o[4];
#pragma unroll
        for (int d0 = 0; d0 < 4; ++d0)
#pragma unroll
            for (int r = 0; r < 16; ++r) o[d0][r] = 0.f;
        float m = -1e30f, l = 0.f;
        attn_loop<128, 128, 128, true, PolC>(lds, P, qr, qa, o, m, l, tid);
        store_ot<4>(o, 1.0f / l, O + (size_t)row * DM + P.h * 128, h2);
    }
}

struct PolD {
    int nchunks, kcol; const bf16* QKV; const bf16* CK; const bf16* CV; int b, kvh, latent;
    int nl, kc0, qpos;
    DI void src(int c, const bf16*& kp, const bf16*& vp, size_t& st) const {
        if (latent && c >= nl) { const size_t off = ((size_t)(b * 512 + 64 * (c - nl)) * 8 + kvh) * 64; kp = CK + off; vp = CV + off; st = 512; }
        else { const int row = latent ? NCTX + b * 1024 + 64 * (kc0 + c) : b * 256 + 64 * c; kp = QKV + (size_t)row * 3072 + 2048 + kvh * 64; vp = kp + 512; st = 3072; }
    }
    DI bool active(int) const { return true; }
    DI void fix(int c, int kt, f32x16& s) const {
        if (latent && c < nl) {
            int h2 = (threadIdx.x >> 5) & 1; asm volatile("" : "+v"(h2));
#pragma unroll
            for (int rr = 0; rr < 16; ++rr) { const int kpos = 64 * (kc0 + c) + 32 * kt + crow(rr, h2); const int d = qpos - kpos;
                s[rr] = (d <= 128 && d >= -128) ? s[rr] * (0.125f * LOG2E) : -INFINITY; }
        } else {
#pragma unroll
            for (int rr = 0; rr < 16; ++rr) s[rr] *= 0.125f * LOG2E;
        }
    }
};
DI void phaseD(const Args& A, ldsp lds, int G, int bid, int tid) {
    const int lane = tid & 63, wave = tid >> 6, r32 = lane & 31, h2 = lane >> 5, g = wave >> 1, qsub = wave & 1;
    const bf16* QKV = (const bf16*)(A.ws + WS_QKV); bf16* O = (bf16*)(A.ws + WS_O);
    for (int u = bid; u < 1024; u += G) {
        PolD P; P.QKV = QKV; P.CK = (const bf16*)(A.ws + WS_CDK); P.CV = (const bf16*)(A.ws + WS_CDV); P.kcol = 0;
        int row;
        if (u < 512) { P.latent = 0; P.b = u >> 5; P.kvh = (u >> 2) & 7; P.nchunks = 4; P.nl = 0; P.kc0 = 0; P.qpos = 0; row = P.b * 256 + 64 * (u & 3) + 32 * qsub + r32; }
        else { const int v = u - 512; P.latent = 1; P.b = v >> 7; P.kvh = (v >> 4) & 7; const int qb = v & 15;
            P.kc0 = qb - 2 < 0 ? 0 : qb - 2; const int kc1 = qb + 3 > 15 ? 15 : qb + 3; P.nl = kc1 - P.kc0 + 1; P.nchunks = P.nl + 8;
            P.qpos = 64 * qb + 32 * qsub + r32; row = NCTX + P.b * 1024 + P.qpos; }
        bf16x8 qr[4];
#pragma unroll
        for (int d0 = 0; d0 < 4; ++d0) qr[d0] = *(const bf16x8*)(QKV + (size_t)row * 3072 + P.kvh * 256 + g * 64 + 16 * d0 + 8 * h2);
        f32x16 o[2];
#pragma unroll
        for (int d0 = 0; d0 < 2; ++d0)
#pragma unroll
            for (int r = 0; r < 16; ++r) o[d0][r] = 0.f;
        float m = A.in[31][P.kvh * 4 + g] * LOG2E, l = 1.0f;
        attn_loop<64, 64, 64, false, PolD>(lds, P, qr, lds, o, m, l, tid);
        store_ot<2>(o, 1.0f / l, O + (size_t)row * DM + P.kvh * 256 + g * 64, h2);
    }
}

DI float logsigmoid(float x) { return fminf(x, 0.f) - log1pf(expf(-fabsf(x))); }
DI void mlstm_scan(const float* gates, int rowbase, int h, int dir, float m0, int T, LAS float* At, LAS float* Mt, LAS float* Gt, int lane) {
    float cG = 0.f, cM = m0;
#pragma unroll 1
    for (int seg = 0; seg < T; seg += 256) {
        float gi[4], gf[4];
#pragma unroll
        for (int e = 0; e < 4; ++e) { const int p = seg + lane * 4 + e, t = dir ? T - 1 - p : p; const float* gr = gates + (size_t)(rowbase + t) * 32 + dir * 16 + h;
            gi[e] = gr[0]; gf[e] = logsigmoid(gr[8]); }
        float run = 0.f;
#pragma unroll
        for (int e = 0; e < 4; ++e) { run += gf[e]; gf[e] = run; }
        float pre = run;
#pragma unroll
        for (int o = 1; o < 64; o <<= 1) { const float v = __shfl_up(pre, o); if (lane >= o) pre += v; }
        const float tot = __shfl(pre, 63);
        pre = pre - run + cG;
        float mx = -INFINITY;
#pragma unroll
        for (int e = 0; e < 4; ++e) { gf[e] += pre; gi[e] -= gf[e]; mx = fmaxf(mx, gi[e]); }
        float pm = mx;
#pragma unroll
        for (int o = 1; o < 64; o <<= 1) { const float v = __shfl_up(pm, o); if (lane >= o) pm = fmaxf(pm, v); }
        const float allm = __shfl(pm, 63);
        float ex = __shfl_up(pm, 1); if (lane == 0) ex = -INFINITY;
        float rm = fmaxf(cM, ex);
#pragma unroll
        for (int e = 0; e < 4; ++e) { const int p = seg + lane * 4 + e, t = dir ? T - 1 - p : p; rm = fmaxf(rm, gi[e]); At[t] = gi[e]; Mt[t] = rm; Gt[t] = gf[e]; }
        cG += tot; cM = fmaxf(cM, allm);
    }
}

constexpr int B_PKB = 272, B_PVB = 528, B_KBYTES = 64 * B_PKB, B_VBYTES = 64 * B_PVB, B_BUF = B_KBYTES + B_VBYTES;
constexpr int B_TAB = 2 * B_BUF;
DI void phaseB(const Args& A, ldsp lds, int G, int bid, int tid) {
    const int lane = tid & 63, wave = __builtin_amdgcn_readfirstlane(tid >> 6), r32 = lane & 31, h2 = lane >> 5, i16 = lane & 15, tq = i16 >> 2, tp = i16 & 3, blk = (lane >> 4) & 1;
    const int qsub = wave & 1, dvh = (wave >> 1) & 1, dir = wave >> 2;
    const bf16* QKV = (const bf16*)(A.ws + WS_QKV); bf16* O = (bf16*)(A.ws + WS_O); const float* gates = (const float*)(A.ws + WS_GATES);
    LAS float* At = (LAS float*)(lds + B_TAB); LAS float* Mt = At + 2048; LAS float* Gt = Mt + 2048; LAS float* sx = Gt + 2048;
    ldsp qt = lds + B_TAB + 24576 + 2048;
    LAS float* xb = (LAS float*)lds;
    const float scale = 0.08838834764831845f;
    for (int u = bid; u < 1024; u += G) {
        int latent, b, h, qb, T, rowbase;
        if (u < 512) { latent = 0; b = u >> 5; h = (u >> 2) & 7; qb = u & 3; T = 256; rowbase = b * 256; }
        else { const int v = u - 512; latent = 1; b = v >> 7; h = (v >> 4) & 7; qb = v & 15; T = 1024; rowbase = NCTX + b * 1024; }
        const int nch = T / 64;
        if (wave < 2) {
            const float m0 = latent ? A.in[6][(b * 2 + wave) * 8 + h] : 0.f;
            mlstm_scan(gates, rowbase, h, wave, m0, T, At + wave * 1024, Mt + wave * 1024, Gt + wave * 1024, lane);
        }
        __syncthreads();
        const int t = 64 * qb + 32 * qsub + r32, row = rowbase + t;
        const float Mq = Mt[dir * 1024 + t], Gq = Gt[dir * 1024 + t];
        { bf16x8 qs[2]; stage_ld<128>(qs, QKV + (size_t)(rowbase + 64 * qb) * 6144 + h * 128, 6144, tid); stage_st<128>(qs, qt, B_PKB, tid); }
        const ldsp qa = qt + (32 * qsub + r32) * B_PKB + h2 * 16;
        f32x16 o[4];
#pragma unroll
        for (int d0 = 0; d0 < 4; ++d0)
#pragma unroll
            for (int r = 0; r < 16; ++r) o[d0][r] = 0.f;
        float den = 0.f;
        const int koff = r32 * B_PKB + h2 * 16;
        const int voff = (4 * h2 + tq) * B_PVB + (16 * blk + 4 * tp) * 2 + dvh * 256;
        bf16x8 kst[2], vst[4];
        { const bf16* kp = QKV + (size_t)rowbase * 6144 + 1024 + h * 128; const bf16* vp = QKV + (size_t)rowbase * 6144 + 2048 + h * 256;
          stage_ld<128>(kst, kp, 6144, tid); stage_ld<256>(vst, vp, 6144, tid); }
        for (int c = 0; c < nch; ++c) {
            ldsp kb = lds + (c & 1) * B_BUF; ldsp vb = kb + B_KBYTES;
            stage_st<128>(kst, kb, B_PKB, tid); stage_st<256>(vst, vb, B_PVB, tid);
            __syncthreads();
            if (c + 1 < nch) { const bf16* kp = QKV + (size_t)(rowbase + 64 * (c + 1)) * 6144 + 1024 + h * 128; const bf16* vp = QKV + (size_t)(rowbase + 64 * (c + 1)) * 6144 + 2048 + h * 256;
                stage_ld<128>(kst, kp, 6144, tid); stage_ld<256>(vst, vp, 6144, tid); }
            const bool act = dir ? (c >= qb) : (c <= qb);
            if (act) {
#pragma unroll
                for (int kt = 0; kt < 2; ++kt) {
                    const bool tact = !(c == qb && (dir ? kt < qsub : kt > qsub));
                    if (tact) {
                        f32x16 s; qk_tile_lq<8>(s, kb + koff + 32 * kt * B_PKB, qa);
                        const bool diag = (c == qb); int h2l = h2; asm volatile("" : "+v"(h2l));
#pragma unroll
                        for (int r = 0; r < 16; ++r) { const int si = 64 * c + 32 * kt + crow(r, h2l);
                            const float w = ex2((At[dir * 1024 + si] - Mq) * LOG2E);
                            const bool ok = !diag || (dir ? si >= t : si <= t);
                            const float p = ok ? s[r] * scale * w : 0.f; s[r] = p; den += p; }
                        pv_tile<4>(o, vb + voff + 32 * kt * B_PVB, B_PVB, pack8<0>(s), pack8<1>(s));
                    }
                }
            }
        }
        den = hsum(den);
#ifndef NO_BSTATE
        if (latent) {
            const float m0 = A.in[6][(b * 2 + dir) * 8 + h];
            const float coef = ex2((m0 - Mq) * LOG2E) * scale;
            const bf16* SC = (const bf16*)(A.ws + WS_SC) + ((size_t)((b * 2 + dir) * 8 + h) * 256 + dvh * 128 + r32) * 128 + 8 * h2;
#pragma unroll
            for (int d0 = 0; d0 < 4; ++d0) { f32x16 tmp;
#pragma unroll
                for (int r = 0; r < 16; ++r) tmp[r] = 0.f;
#pragma unroll
                for (int ds = 0; ds < 8; ++ds) { const bf16x8 a = *(const bf16x8*)(SC + (size_t)d0 * 32 * 128 + 16 * ds); const bf16x8 qf = *(const LAS bf16x8*)(qa + 32 * ds); tmp = MFMA32(a, qf, tmp); }
#pragma unroll
                for (int r = 0; r < 16; ++r) o[d0][r] += coef * tmp[r]; }
            const float* n0 = A.in[5] + ((b * 2 + dir) * 8 + h) * 128 + 8 * h2;
            float dot = 0.f;
#pragma unroll
            for (int ds = 0; ds < 8; ++ds) { const bf16x8 qf = *(const LAS bf16x8*)(qa + 32 * ds);
#pragma unroll
                for (int jj = 0; jj < 8; ++jj) dot += bf2f((unsigned short)qf[jj]) * n0[16 * ds + jj]; }
            dot = hsum(dot);
            den += coef * dot;
        }
#endif
        const float hinv = 1.0f / fmaxf(fabsf(den), __expf(-(Gq + Mq)));
        __syncthreads();
        if (dir == 1) {
#pragma unroll
            for (int d0 = 0; d0 < 4; ++d0)
#pragma unroll
                for (int r = 0; r < 16; ++r) xb[(((wave & 3) * 4 + d0) * 16 + r) * 64 + lane] = o[d0][r] * hinv;
        }
        __syncthreads();
        float ss = 0.f;
        if (dir == 0) {
#pragma unroll
            for (int d0 = 0; d0 < 4; ++d0)
#pragma unroll
                for (int r = 0; r < 16; ++r) { const float v = o[d0][r] * hinv + xb[((wave * 4 + d0) * 16 + r) * 64 + lane]; o[d0][r] = v; ss += v * v; }
            ss = hsum(ss);
            if (h2 == 0) sx[wave * 32 + r32] = ss;
        }
        __syncthreads();
        if (dir == 0) {
            const float tot = ss + sx[(wave ^ 2) * 32 + r32];
            const float rs = 1.0f / sqrtf(tot * (1.f / 256.f) + RMS_EPS);
            const float* nw = A.in[25] + h * 256 + dvh * 128; const bf16* og = QKV + (size_t)row * 6144 + 4096 + h * 256 + dvh * 128;
#pragma unroll
            for (int d0 = 0; d0 < 4; ++d0)
#pragma unroll
                for (int g = 0; g < 4; ++g) { const int dv = 32 * d0 + 8 * g + 4 * h2;
                    const u32x2 ow = *(const u32x2*)(og + dv); const f32x4 nv = *(const f32x4*)(nw + dv);
                    const float g0 = 1.f / (1.f + __expf(-bflo(ow.x))), g1 = 1.f / (1.f + __expf(-bfhi(ow.x))), g2 = 1.f / (1.f + __expf(-bflo(ow.y))), g3 = 1.f / (1.f + __expf(-bfhi(ow.y)));
                    u32x2 w; w.x = pk2(o[d0][4 * g] * rs * nv[0] * g0, o[d0][4 * g + 1] * rs * nv[1] * g1); w.y = pk2(o[d0][4 * g + 2] * rs * nv[2] * g2, o[d0][4 * g + 3] * rs * nv[3] * g3);
                    *(u32x2*)(O + (size_t)row * DM + h * 256 + dvh * 128 + dv) = w; }
        }
        __syncthreads();
    }
    LAS float* Wt = sx + 256;
#ifndef NO_BFINAL
    for (int u = bid; u < 256; u += G) {
        const int b = u >> 4, h = (u >> 1) & 7, sd = u & 1, rowbase = b * 256;
        if (wave == 0) mlstm_scan(gates, rowbase, h, sd, 0.f, 256, At, Mt, Gt, lane);
        __syncthreads();
        const int tl = sd ? 0 : 255;
        const float MT = Mt[tl], GT = Gt[tl];
        if (tid < 256) Wt[tid] = ex2((At[tid] - MT) * LOG2E);
        __syncthreads();
        f32x16 acc[4];
#pragma unroll
        for (int nt = 0; nt < 4; ++nt)
#pragma unroll
            for (int r = 0; r < 16; ++r) acc[nt][r] = 0.f;
        float nacc = 0.f;
        const int aoff = (8 * h2 + tq) * B_PVB + (32 * wave + 16 * blk + 4 * tp) * 2;
        const int boff = (8 * h2 + tq) * B_PKB + (16 * blk + 4 * tp) * 2;
        bf16x8 kst[2], vst[4];
        { const bf16* kp = QKV + (size_t)rowbase * 6144 + 1024 + h * 128; const bf16* vp = QKV + (size_t)rowbase * 6144 + 2048 + h * 256;
          stage_ld<128>(kst, kp, 6144, tid); stage_ld<256>(vst, vp, 6144, tid); }
        for (int c = 0; c < 4; ++c) {
            ldsp kb = lds + (c & 1) * B_BUF; ldsp vb = kb + B_KBYTES;
#pragma unroll
            for (int i = 0; i < 4; ++i) { const int idx = tid + NTHR * i, rw = idx / 32; const float w = Wt[64 * c + rw];
                const u32x4 x = __builtin_bit_cast(u32x4, vst[i]); u32x4 y;
                y.x = pk2(bflo(x.x) * w, bfhi(x.x) * w); y.y = pk2(bflo(x.y) * w, bfhi(x.y) * w); y.z = pk2(bflo(x.z) * w, bfhi(x.z) * w); y.w = pk2(bflo(x.w) * w, bfhi(x.w) * w);
                vst[i] = __builtin_bit_cast(bf16x8, y); }
            stage_st<128>(kst, kb, B_PKB, tid); stage_st<256>(vst, vb, B_PVB, tid);
            __syncthreads();
            if (c + 1 < 4) { const bf16* kp = QKV + (size_t)(rowbase + 64 * (c + 1)) * 6144 + 1024 + h * 128; const bf16* vp = QKV + (size_t)(rowbase + 64 * (c + 1)) * 6144 + 2048 + h * 256;
                stage_ld<128>(kst, kp, 6144, tid); stage_ld<256>(vst, vp, 6144, tid); }
#pragma unroll
            for (int ks = 0; ks < 4; ++ks) {
                const s16x4 al = tr_read(vb + aoff + 16 * ks * B_PVB), ah = tr_read(vb + aoff + (16 * ks + 4) * B_PVB);
                const bf16x8 a = {al[0], al[1], al[2], al[3], ah[0], ah[1], ah[2], ah[3]};
#pragma unroll
                for (int nt = 0; nt < 4; ++nt) {
                    const s16x4 bl = tr_read(kb + boff + 16 * ks * B_PKB + 64 * nt), bh = tr_read(kb + boff + (16 * ks + 4) * B_PKB + 64 * nt);
                    const bf16x8 bb = {bl[0], bl[1], bl[2], bl[3], bh[0], bh[1], bh[2], bh[3]};
                    acc[nt] = MFMA32(a, bb, acc[nt]);
                }
            }
            if (tid < 128) {
#pragma unroll 8
                for (int s = 0; s < 64; ++s) nacc += Wt[64 * c + s] * bf2f(*(const LAS unsigned short*)(kb + s * B_PKB + tid * 2));
            }
        }
        float* oc = A.out + O_BC + ((size_t)((b * 2 + sd) * 8 + h) * 256) * 128;
#pragma unroll
        for (int nt = 0; nt < 4; ++nt)
#pragma unroll
            for (int r = 0; r < 16; ++r) oc[(size_t)(32 * wave + crow(r, h2)) * 128 + 32 * nt + r32] = acc[nt][r];
        if (tid < 128) A.out[O_BN + ((b * 2 + sd) * 8 + h) * 128 + tid] = nacc;
        if (tid == 0) A.out[O_BM + (b * 2 + sd) * 8 + h] = GT + MT;
        __syncthreads();
    }
#endif
}

constexpr int N_PHASES = 3 + 7 * NLAYER;
#define PH(b) ((MASK >> (b)) & 1)
template <int MASK> __global__ void __launch_bounds__(NTHR, 2) fwd_kernel(Args args) {
    extern __shared__ __attribute__((aligned(16))) unsigned char lds_raw[];
    ldsp lds = (ldsp)lds_raw;
    const int tid0 = threadIdx.x, bid = blockIdx.x, G = gridDim.x;
#define TIDL() ({ int t_ = threadIdx.x; asm volatile("" : "+v"(t_)); t_; })
    const int tid = tid0;
    volatile LAS unsigned* MISC = (volatile LAS unsigned*)(lds + MISC_OFF);
    for (int u = tid; u < 64; u += NTHR) MISC[u] = 0u;
    __syncthreads();
    const int lo = args.ph_lo, hi = args.ph_hi;
    unsigned* ctl = (unsigned*)(args.ws + WS_CTL);
    XcdBarrier bar; bar.bar = ctl + CW_BAR; bar.x = 0; bar.st = nullptr;
    const bool multi = (hi - lo) > 1;
    if (multi) bar = xcd_barrier_post(ctl + CW_BAR, MISC + 8);
#define IN(k) (lo <= (k) && (k) < hi)
#define SEAM(k) do { if (IN(k) && IN((k) + 1)) xcd_barrier(bar); } while (0)
    unsigned char* ws = args.ws;
    bf16* Hb = (bf16*)(ws + WS_H); bf16* QKVb = (bf16*)(ws + WS_QKV); bf16* Ob = (bf16*)(ws + WS_O); float* Yb = (float*)(ws + WS_Y); bf16* Ub = (bf16*)(ws + WS_U);

    if (PH(0) && IN(0)) { p0a_prologue(args, lds, G, bid, TIDL()); } SEAM(0);
    if (PH(1) && IN(1)) { p0b_modreduce(args, G, bid, TIDL()); } SEAM(1);
    if (PH(2) && IN(2)) { RowP P; P.Y = nullptr; P.mod_gate = 0; P.Lg = 0; P.gpost = 0; P.has_next = 1; P.Ln = 0; P.gpre = 0; P.mod_shift = 0; P.do_gates = 0; row_phase(args, P, lds, G, bid, TIDL()); } SEAM(2);

    for (int L = 0; L < NLAYER; ++L) {
        const int base = 3 + 7 * L;
        if (PH(3) && IN(base)) {
            pg8::EpiInProj E; E.O = QKVb; E.rtab = (const float*)(ws + WS_ROPE);
            const bf16* Wt; int N;
            if (L == 0)      { Wt = (const bf16*)(ws + W_AIN); N = 6144; E.ck = args.out + O_AK; E.cv = args.out + O_AV; E.kc0 = 2048; E.vc0 = 4096; E.kw = 2048; E.rope_cols = 4096; }
            else if (L == 1) { Wt = (const bf16*)(ws + W_BIN); N = 6144; E.ck = nullptr; E.cv = nullptr; E.kc0 = 0; E.vc0 = 0; E.kw = 0; E.rope_cols = 0; }
            else if (L == 2) { Wt = (const bf16*)(ws + W_CIN); N = 6144; E.ck = args.out + O_CK; E.cv = args.out + O_CV; E.kc0 = 2048; E.vc0 = 4096; E.kw = 2048; E.rope_cols = 0; }
            else             { Wt = (const bf16*)(ws + W_DIN); N = 3072; E.ck = args.out + O_DK; E.cv = args.out + O_DV; E.kc0 = 2048; E.vc0 = 2560; E.kw = 512; E.rope_cols = 2560; }
            E.ldc = N;
            pg8::Gemm g{Hb, Wt, NTOK, N, DM}; pg8::StaticOrder S; S.init(NTOK, N, G, bid);
            pg8::gemm_phase<pg8::EpiInProj, pg8::StaticOrder, true, true>((LAS unsigned char*)lds, g, S, E);
        }
        SEAM(base);
        if (IN(base + 1)) {
            if (PH(4) && L == 0) phaseA(args, lds, G, bid, TIDL());
            if (PH(5) && L == 1) phaseB(args, lds, G, bid, TIDL());
            if (PH(6) && L == 2) phaseC(args, lds, G, bid, TIDL());
            if (PH(7) && L == 3) phaseD(args, lds, G, bid, TIDL());
        }
        SEAM(base + 1);
        if (PH(8) && IN(base + 2)) {
            const size_t wo = L == 0 ? W_AOUT : (L == 1 ? W_BOUT : (L == 2 ? W_COUT : W_DOUT));
            pg8::Gemm g{Ob, (const bf16*)(ws + wo), NTOK, DM, DM}; pg8::StaticOrder S; S.init(NTOK, DM, G, bid);
            pg8::EpiF32 E{Yb, DM};
            pg8::gemm_phase<pg8::EpiF32, pg8::StaticOrder, true, true>((LAS unsigned char*)lds, g, S, E);
        }
        SEAM(base + 2);
        if (PH(2) && IN(base + 3)) { RowP P; P.Y = Yb; P.mod_gate = 2; P.Lg = L; P.gpost = L * 4 + 1; P.has_next = 1; P.Ln = L; P.gpre = L * 4 + 2; P.mod_shift = 3; P.do_gates = 0; row_phase(args, P, lds, G, bid, TIDL()); }
        SEAM(base + 3);
        if (PH(9) && IN(base + 4)) {
            pg8::Gemm g{Hb, (const bf16*)(ws + W_FF1) + (size_t)L * DM * DFF, NTOK, DFF, DM}; pg8::StaticOrder S; S.init(NTOK, DFF, G, bid);
            pg8::EpiSqRelu E{Ub, DFF};
            pg8::gemm_phase<pg8::EpiSqRelu, pg8::StaticOrder, true, true>((LAS unsigned char*)lds, g, S, E);
        }
        SEAM(base + 4);
        if (PH(10) && IN(base + 5)) {
            pg8::Gemm g{Ub, (const bf16*)(ws + W_FF2) + (size_t)L * DM * DFF, NTOK, DM, DFF}; pg8::StaticOrder S; S.init(NTOK, DM, G, bid);
            pg8::EpiF32 E{Yb, DM};
            pg8::gemm_phase<pg8::EpiF32, pg8::StaticOrder, true, true>((LAS unsigned char*)lds, g, S, E);
        }
        SEAM(base + 5);
        if (PH(2) && IN(base + 6)) { RowP P; P.Y = Yb; P.mod_gate = 5; P.Lg = L; P.gpost = L * 4 + 3; P.has_next = (L + 1 < NLAYER); P.Ln = L + 1; P.gpre = (L + 1) * 4; P.mod_shift = 0; P.do_gates = (L + 1 == 1); row_phase(args, P, lds, G, bid, TIDL()); }
        SEAM(base + 6);
    }
#undef IN
#undef SEAM
}

#ifndef MK_PER_PHASE
#define MK_PER_PHASE 0
#endif
template <int MASK> static int setup_kernel() {
    if (hipFuncSetAttribute((const void*)fwd_kernel<MASK>, hipFuncAttributeMaxDynamicSharedMemorySize, LDS_BYTES) != hipSuccess) { fprintf(stderr, "kernel_launch: hipFuncSetAttribute failed (mask %x)\n", MASK); return -1; }
    return 0;
}
template <int MASK> static void launch_range(const Args& a, int grid, hipStream_t stream) { hipLaunchKernelGGL(fwd_kernel<MASK>, dim3(grid), dim3(NTHR), LDS_BYTES, stream, a); }
extern "C" void kernel_launch(void* const* d_in, const int* in_sizes, int n_in, void* d_out, int out_size, void* d_ws, size_t ws_size, hipStream_t stream) {
    static int grid = 0;
    if (grid == 0) {
        if (n_in != 32 || out_size != (int)O_END || ws_size < WS_END) { fprintf(stderr, "kernel_launch: unexpected shapes: n_in %d out %d ws %zu (need %zu)\n", n_in, out_size, ws_size, (size_t)WS_END); grid = -1; return; }
        int dev = 0, cus = 0;
        if (hipGetDevice(&dev) != hipSuccess || hipDeviceGetAttribute(&cus, hipDeviceAttributeMultiprocessorCount, dev) != hipSuccess) { grid = -1; return; }
#if MK_PER_PHASE
        if (setup_kernel<1>() || setup_kernel<2>() || setup_kernel<4>() || setup_kernel<8>() || setup_kernel<16>() || setup_kernel<32>() || setup_kernel<64>() || setup_kernel<128>() || setup_kernel<256>() || setup_kernel<512>() || setup_kernel<1024>()) { grid = -1; return; }
#else
        if (setup_kernel<0xFFFF>()) { grid = -1; return; }
#endif
        (void)hipGetLastError();
        grid = cus;
    }
    if (grid < 0) return;
    (void)hipMemsetAsync((char*)d_ws + WS_CTL, 0, CTL_ZERO_BYTES, stream);
    Args a{};
    for (int i = 0; i < 32; ++i) a.in[i] = (const float*)d_in[i];
    a.out = (float*)d_out; a.ws = (unsigned char*)d_ws;
#if MK_PER_PHASE
    for (int p = 0; p < N_PHASES; ++p) {
        a.ph_lo = p; a.ph_hi = p + 1;
        if (p == 0) launch_range<1>(a, grid, stream);
        else if (p == 1) launch_range<2>(a, grid, stream);
        else if (p == 2) launch_range<4>(a, grid, stream);
        else { const int L = (p - 3) / 7, k = (p - 3) % 7;
            if (k == 0) launch_range<8>(a, grid, stream);
            else if (k == 1) { if (L == 0) launch_range<16>(a, grid, stream); else if (L == 1) launch_range<32>(a, grid, stream); else if (L == 2) launch_range<64>(a, grid, stream); else launch_range<128>(a, grid, stream); }
            else if (k == 2) launch_range<256>(a, grid, stream);
            else if (k == 3 || k == 6) launch_range<4>(a, grid, stream);
            else if (k == 4) launch_range<512>(a, grid, stream);
            else launch_range<1024>(a, grid, stream);
        }
    }
#else
    a.ph_lo = 0; a.ph_hi = N_PHASES; launch_range<0xFFFF>(a, grid, stream);
#endif
    const hipError_t le = hipPeekAtLastError();
    if (le != hipSuccess) fprintf(stderr, "kernel_launch: launch failed: %s\n", hipGetErrorName(le));
}
```

```cpp
#include <hip/hip_runtime.h>
#include <cstdio>
#include <cstdint>
#include <cmath>
namespace pg8 {
#define PG8_LAS __attribute__((address_space(3)))
typedef unsigned short bf16_t;
typedef short bf16x8 __attribute__((ext_vector_type(8)));
typedef float f32x4 __attribute__((ext_vector_type(4)));
typedef unsigned u32x4 __attribute__((ext_vector_type(4)));
constexpr int BM = 256, BK = 64, HALF = 128, HTB = HALF * BK * 2  , STAGE_BYTES = 8 * HTB, NXCD = 8, WGM = 8;

__host__ __device__ __forceinline__ int lds_byte(int r, int c) { const int st = (r >> 4) * 2 + (c >> 5), rr = r & 15, cc = c & 31, ob = rr * 64 + cc * 2; return st * 1024 + (ob ^ (((ob >> 9) & 1) << 5)); }
__host__ __device__ __forceinline__ void stage_rc(int b, int& R, int& C) { const int st = b / 1024, sb = b % 1024, swz = sb ^ (((sb >> 9) & 1) << 5); R = (st >> 1) * 16 + swz / 64; C = (st & 1) * 32 + (swz % 64) / 2; }
__host__ __device__ __forceinline__ int perm32(int rho) { const int n = rho >> 4, i = rho & 15; return 8 * (i >> 2) + 4 * n + (i & 3); }

struct Unit { int pm, pn; };
struct Gemm { const bf16_t* A; const bf16_t* Bt; int M, N, K; };

struct StaticOrder {
    int nM, nN, nwg, G, c;
    __host__ __device__ void init(int M, int N, int G_, int c_) { nM = M / BM; nN = N / BM; nwg = nM * nN; G = G_; c = c_; }
    __host__ __device__ bool next(int i, Unit& u) const {
        const long L = (long)i * G + c; if (L >= nwg) return false;
        int wgid = (int)L; { const int q = nwg / NXCD, r = nwg % NXCD, xcd = wgid % NXCD, off = wgid / NXCD; wgid = (xcd < r ? xcd * (q + 1) : r * (q + 1) + (xcd - r) * q) + off; }
        const int nig = WGM * nN, gid = wgid / nig, fm = gid * WGM, gsz = (nM - fm) < WGM ? (nM - fm) : WGM;
        u.pm = fm + ((wgid % nig) % gsz); u.pn = (wgid % nig) / gsz; return true;
    }
    __device__ __forceinline__ void a_ready(const Unit&) const {}
    __device__ __forceinline__ void done(const Unit&) const {}
};

__device__ __forceinline__ unsigned cvt_pk_bf16(float lo, float hi) { unsigned r; asm volatile("v_cvt_pk_bf16_f32 %0, %1, %2" : "=v"(r) : "v"(lo), "v"(hi)); return r; }
typedef float f32x2 __attribute__((ext_vector_type(2)));

struct EpiF32 {
    static constexpr bool PERM = false, AFTER_DRAIN = false;
    float* C; int ldc;
    __device__ __forceinline__ void operator()(const f32x4 (&acc)[2][2][4][2], const Unit& u, int wr, int wc, int fr, int fq) const {
        const int row0 = u.pm * BM + wr * 64 + fr, col0 = u.pn * BM + wc * 32 + 4 * fq;
#pragma unroll
        for (int ai = 0; ai < 2; ++ai)
#pragma unroll
            for (int m = 0; m < 4; ++m) { float* rowp = C + (size_t)(row0 + ai * HALF + m * 16) * ldc + col0;
#pragma unroll
                for (int bj = 0; bj < 2; ++bj)
#pragma unroll
                    for (int n = 0; n < 2; ++n) *(f32x4*)(rowp + bj * HALF + n * 16) = acc[ai][bj][m][n]; }
    }
};
template <bool ACT> struct EpiBf16 {
    static constexpr bool PERM = true, AFTER_DRAIN = false;
    bf16_t* O; int ldc;
    __device__ __forceinline__ void operator()(const f32x4 (&acc)[2][2][4][2], const Unit& u, int wr, int wc, int fr, int fq) const {
        const int row0 = u.pm * BM + wr * 64 + fr, col0 = u.pn * BM + wc * 32 + 8 * fq;
#pragma unroll
        for (int ai = 0; ai < 2; ++ai)
#pragma unroll
            for (int m = 0; m < 4; ++m) { bf16_t* rowp = O + (size_t)(row0 + ai * HALF + m * 16) * ldc + col0;
#pragma unroll
                for (int bj = 0; bj < 2; ++bj) { f32x4 v0 = acc[ai][bj][m][0], v1 = acc[ai][bj][m][1];
#pragma unroll
                    for (int e = 0; e < 4; ++e) { if (ACT) { const float a = fmaxf(v0[e], 0.f), b = fmaxf(v1[e], 0.f); v0[e] = a * a; v1[e] = b * b; } }
                    u32x4 w; w.x = cvt_pk_bf16(v0[0], v0[1]); w.y = cvt_pk_bf16(v0[2], v0[3]); w.z = cvt_pk_bf16(v1[0], v1[1]); w.w = cvt_pk_bf16(v1[2], v1[3]);
                    *(u32x4*)(rowp + bj * HALF) = w; } }
    }
};
struct EpiInProj {
    static constexpr bool PERM = true, AFTER_DRAIN = false;
    bf16_t* O; int ldc;
    float* ck; float* cv;
    int kc0, vc0, kw;
    int rope_cols;
    const float* rtab;
    __device__ __forceinline__ void operator()(const f32x4 (&acc)[2][2][4][2], const Unit& u, int wr, int wc, int fr, int fq) const {
        const int row0 = u.pm * BM + wr * 64 + fr, colt = u.pn * BM, col0 = colt + wc * 32 + 8 * fq;
        float* cdst = nullptr; int ccol = 0;
        if (u.pm < 16 && ck != nullptr) {
            if (colt >= kc0 && colt < kc0 + kw) { cdst = ck; ccol = col0 - kc0; }
            else if (colt >= vc0 && colt < vc0 + kw) { cdst = cv; ccol = col0 - vc0; }
        }
        const bool rope = (u.pm >= 16) && (colt < rope_cols);
#pragma unroll
        for (int ai = 0; ai < 2; ++ai)
#pragma unroll
            for (int m = 0; m < 4; ++m) {
                const int row = row0 + ai * HALF + m * 16;
                bf16_t* rowp = O + (size_t)row * ldc + col0;
                int pos = 0; if (rope) { const int t = row & 1023; pos = (wc & 1) ? (t & 63) : (t >> 6); }
                const f32x4* tb = (const f32x4*)(rtab + (pos * 16 + 8 * (fq & 1)) * 2);
#pragma unroll
                for (int bj = 0; bj < 2; ++bj) { f32x4 v0 = acc[ai][bj][m][0], v1 = acc[ai][bj][m][1];
                    if (rope) {
                        const f32x4 t0 = tb[0], t1 = tb[1], t2 = tb[2], t3 = tb[3];
                        const float cs[8] = {t0[0], t0[2], t1[0], t1[2], t2[0], t2[2], t3[0], t3[2]};
                        const float sn[8] = {t0[1], t0[3], t1[1], t1[3], t2[1], t2[3], t3[1], t3[3]};
#pragma unroll
                        for (int e = 0; e < 4; ++e) {
                            const float a = v0[e], pa = __shfl_xor(a, 32), b = v1[e], pb = __shfl_xor(b, 32);
                            v0[e] = (fq < 2) ? a * cs[e] - pa * sn[e] : pa * sn[e] + a * cs[e];
                            v1[e] = (fq < 2) ? b * cs[4 + e] - pb * sn[4 + e] : pb * sn[4 + e] + b * cs[4 + e];
                        }
                    }
                    u32x4 w; w.x = cvt_pk_bf16(v0[0], v0[1]); w.y = cvt_pk_bf16(v0[2], v0[3]); w.z = cvt_pk_bf16(v1[0], v1[1]); w.w = cvt_pk_bf16(v1[2], v1[3]);
                    *(u32x4*)(rowp + bj * HALF) = w;
                    if (cdst) { float* cp = cdst + (size_t)row * kw + ccol + bj * HALF; *(f32x4*)cp = v0; *(f32x4*)(cp + 4) = v1; }
                } }
    }
};

template <class Epi, class Sched, bool ALIGN_EPI = false, bool SP2 = false>
__device__ __forceinline__ void gemm_phase(PG8_LAS unsigned char* lds, const Gemm g, const Sched& S, const Epi& E) {
    int tid_raw = threadIdx.x; asm volatile("" : "+v"(tid_raw));
    const int tid = tid_raw, wid = __builtin_amdgcn_readfirstlane(tid >> 6), lane = tid & 63, wr = wid >> 2, wc = wid & 3, fr = lane & 15, fq = lane >> 4;
    const int K = g.K, nt = K / BK;
    unsigned voffA[2], voffB[2];
#pragma unroll
    for (int i = 0; i < 2; ++i) { int R, C; stage_rc(tid * 16 + i * 8192, R, C); const int Rb = Epi::PERM ? ((R & ~31) + perm32(R & 31)) : R;
        voffA[i] = (unsigned)(R * K + C) * 2u; voffB[i] = (unsigned)(Rb * K + C) * 2u; }
    const size_t kstep = (size_t)(BK * 2);
    const size_t hstep = (size_t)HALF * K * 2;
    const size_t tstep = 2 * hstep;
    const unsigned ldsw = (unsigned)wid * 1024u;
    const int aoff = lds_byte(wr * 64 + fr, fq * 8), boff = lds_byte(wc * 32 + fr, fq * 8);
#define PG8_SA(b, h) (((b) * 2 + (h)) * HTB)
#define PG8_SB(b, h) ((4 + (b) * 2 + (h)) * HTB)
#define PG8_STAGE(bufoff, gbase, voff) do { _Pragma("unroll") for (int _i = 0; _i < 2; ++_i) \
        __builtin_amdgcn_global_load_lds((const unsigned*)((const char*)(gbase) + (voff)[_i]), (PG8_LAS unsigned*)(lds + (bufoff) + ldsw + _i * 8192), 16, 0, 0); } while (0)
#define PG8_LDA(dst, b, h) do { _Pragma("unroll") for (int m = 0; m < 4; ++m) _Pragma("unroll") for (int k = 0; k < 2; ++k) dst[m][k] = *(const PG8_LAS bf16x8*)(lds + PG8_SA(b, h) + aoff + m * 2048 + k * 1024); } while (0)
#define PG8_LDB(dst, b, h) do { _Pragma("unroll") for (int n = 0; n < 2; ++n) _Pragma("unroll") for (int k = 0; k < 2; ++k) dst[n][k] = *(const PG8_LAS bf16x8*)(lds + PG8_SB(b, h) + boff + n * 2048 + k * 1024); } while (0)
#define PG8_MMA(ai, bj, At, Bt) do { __builtin_amdgcn_s_setprio(1); _Pragma("unroll") for (int m = 0; m < 4; ++m) _Pragma("unroll") for (int n = 0; n < 2; ++n) _Pragma("unroll") for (int k = 0; k < 2; ++k) \
        acc[ai][bj][m][n] = __builtin_amdgcn_mfma_f32_16x16x32_bf16(Bt[n][k], At[m][k], acc[ai][bj][m][n], 0, 0, 0); __builtin_amdgcn_s_setprio(0); } while (0)
#define PG8_WAIT_V(n) asm volatile("s_waitcnt vmcnt(" #n ")" ::: "memory")
#define PG8_WAIT_L(n) asm volatile("s_waitcnt lgkmcnt(" #n ")" ::: "memory")
#define PG8_BAR __builtin_amdgcn_s_barrier()
#define PG8_SCHED __builtin_amdgcn_sched_barrier(0)
    Unit cur, nxt; int ui = 0;
    if (!S.next(0, cur)) return;
    f32x4 acc[2][2][4][2];
#pragma unroll
    for (int a = 0; a < 2; ++a)
#pragma unroll
        for (int b = 0; b < 2; ++b)
#pragma unroll
            for (int m = 0; m < 4; ++m)
#pragma unroll
                for (int n = 0; n < 2; ++n) acc[a][b][m][n] = (f32x4){0.f, 0.f, 0.f, 0.f};
    bf16x8 At[4][2], B0[2][2], B1[2][2];
    const char* cA = (const char*)g.A + (size_t)cur.pm * tstep; const char* cB = (const char*)g.Bt + (size_t)cur.pn * tstep;
    S.a_ready(cur);
    if constexpr (SP2) {
        PG8_STAGE(PG8_SB(0, 0), cB, voffB); PG8_STAGE(PG8_SB(0, 1), cB + hstep, voffB); PG8_STAGE(PG8_SA(0, 0), cA, voffA); PG8_STAGE(PG8_SA(0, 1), cA + hstep, voffA);
        if (wr == 1) PG8_BAR;
        PG8_WAIT_V(2); PG8_BAR;
        PG8_STAGE(PG8_SB(1, 0), cB + kstep, voffB); PG8_STAGE(PG8_SA(1, 0), cA + kstep, voffA); PG8_STAGE(PG8_SB(1, 1), cB + hstep + kstep, voffB);
        PG8_WAIT_V(6); PG8_BAR;
    } else {
        PG8_STAGE(PG8_SB(0, 0), cB, voffB); PG8_STAGE(PG8_SA(0, 0), cA, voffA); PG8_STAGE(PG8_SB(0, 1), cB + hstep, voffB); PG8_STAGE(PG8_SA(0, 1), cA + hstep, voffA);
        if (wr == 1) PG8_BAR;
        PG8_WAIT_V(4); PG8_BAR;
        PG8_STAGE(PG8_SB(1, 0), cB + kstep, voffB); PG8_STAGE(PG8_SA(1, 0), cA + kstep, voffA); PG8_STAGE(PG8_SB(1, 1), cB + hstep + kstep, voffB);
        PG8_WAIT_V(6); PG8_BAR;
    }
    for (;;) {
        const bool has_next = S.next(ui + 1, nxt);
        const char* nA = has_next ? (const char*)g.A + (size_t)nxt.pm * tstep : cA; const char* nB = has_next ? (const char*)g.Bt + (size_t)nxt.pn * tstep : cB;
        for (int t = 0; t < nt; t += 2) {
            const bool last = (t == nt - 2);
            const char* a1 = cA + (size_t)(t + 1) * kstep;
            const char* a2 = last ? nA : cA + (size_t)(t + 2) * kstep; const char* b2 = last ? nB : cB + (size_t)(t + 2) * kstep;
            const char* a3 = a2 + kstep; const char* b3 = b2 + kstep;
            if (last && has_next) S.a_ready(nxt);
            if constexpr (SP2) {
            PG8_LDB(B0, 0, 0); PG8_LDB(B1, 0, 1); PG8_SCHED; PG8_LDA(At, 0, 0); PG8_STAGE(PG8_SA(1, 1), a1 + hstep, voffA);
            PG8_WAIT_V(8); PG8_WAIT_L(0); PG8_BAR; PG8_MMA(0, 0, At, B0); PG8_MMA(0, 1, At, B1); PG8_BAR; PG8_SCHED;
            PG8_LDA(At, 0, 1); PG8_STAGE(PG8_SB(0, 0), b2, voffB); PG8_STAGE(PG8_SB(0, 1), b2 + hstep, voffB); PG8_STAGE(PG8_SA(0, 0), a2, voffA);
            PG8_WAIT_V(8); PG8_WAIT_L(0); PG8_BAR; PG8_MMA(1, 0, At, B0); PG8_MMA(1, 1, At, B1); PG8_BAR; PG8_SCHED;
            PG8_LDB(B0, 1, 0); PG8_LDB(B1, 1, 1); PG8_SCHED; PG8_LDA(At, 1, 0); PG8_STAGE(PG8_SA(0, 1), a2 + hstep, voffA);
            PG8_WAIT_V(8); PG8_WAIT_L(0); PG8_BAR; PG8_MMA(0, 0, At, B0); PG8_MMA(0, 1, At, B1); PG8_BAR; PG8_SCHED;
            PG8_LDA(At, 1, 1); PG8_STAGE(PG8_SB(1, 0), b3, voffB); PG8_STAGE(PG8_SB(1, 1), b3 + hstep, voffB); PG8_STAGE(PG8_SA(1, 0), a3, voffA);
            PG8_WAIT_V(8); PG8_WAIT_L(0); PG8_BAR; PG8_MMA(1, 0, At, B0); PG8_MMA(1, 1, At, B1); PG8_BAR; PG8_SCHED;
            } else {
            PG8_LDB(B0, 0, 0); PG8_SCHED; PG8_LDA(At, 0, 0); PG8_STAGE(PG8_SA(1, 1), a1 + hstep, voffA);
            PG8_WAIT_L(8); PG8_BAR; PG8_WAIT_L(0); PG8_MMA(0, 0, At, B0); PG8_BAR; PG8_SCHED;
            PG8_LDB(B1, 0, 1); PG8_STAGE(PG8_SB(0, 0), b2, voffB);
            PG8_BAR; PG8_WAIT_L(0); PG8_MMA(0, 1, At, B1); PG8_BAR;
            PG8_LDA(At, 0, 1); PG8_STAGE(PG8_SA(0, 0), a2, voffA);
            PG8_BAR; PG8_WAIT_L(0); PG8_MMA(1, 0, At, B0); PG8_BAR; PG8_SCHED;
            PG8_STAGE(PG8_SB(0, 1), b2 + hstep, voffB);
            PG8_WAIT_V(6); PG8_BAR; PG8_MMA(1, 1, At, B1); PG8_BAR;
            PG8_LDB(B0, 1, 0); PG8_SCHED; PG8_LDA(At, 1, 0); PG8_STAGE(PG8_SA(0, 1), a2 + hstep, voffA);
            PG8_WAIT_L(8); PG8_BAR; PG8_WAIT_L(0); PG8_MMA(0, 0, At, B0); PG8_BAR; PG8_SCHED;
            PG8_LDB(B1, 1, 1); PG8_STAGE(PG8_SB(1, 0), b3, voffB);
            PG8_BAR; PG8_WAIT_L(0); PG8_MMA(0, 1, At, B1); PG8_BAR;
            PG8_LDA(At, 1, 1); PG8_STAGE(PG8_SA(1, 0), a3, voffA);
            PG8_BAR; PG8_WAIT_L(0); PG8_MMA(1, 0, At, B0); PG8_BAR; PG8_SCHED;
            PG8_STAGE(PG8_SB(1, 1), b3 + hstep, voffB);
            PG8_WAIT_V(6); PG8_BAR; PG8_MMA(1, 1, At, B1); PG8_BAR;
            }
        }
        if constexpr (ALIGN_EPI) { if (wr == 0) PG8_BAR; }
        if constexpr (!Epi::AFTER_DRAIN) { E(acc, cur, wr, wc, fr, fq); S.done(cur); }
        if (!has_next) break;
#pragma unroll
        for (int a = 0; a < 2; ++a)
#pragma unroll
            for (int b = 0; b < 2; ++b)
#pragma unroll
                for (int m = 0; m < 4; ++m)
#pragma unroll
                    for (int n = 0; n < 2; ++n) acc[a][b][m][n] = (f32x4){0.f, 0.f, 0.f, 0.f};
        cur = nxt; cA = nA; cB = nB; ++ui;
        if constexpr (ALIGN_EPI) { if (wr == 1) PG8_BAR; }
    }
    PG8_WAIT_V(0);
    if constexpr (!ALIGN_EPI) { if (wr == 0) PG8_BAR; }
    PG8_BAR;
    if constexpr (Epi::AFTER_DRAIN) { E.fused(acc, cur, wr, wc, fr, fq, lds, wid, lane); S.done(cur); }
#undef PG8_SA
#undef PG8_SB
#undef PG8_STAGE
#undef PG8_LDA
#undef PG8_LDB
#undef PG8_MMA
#undef PG8_WAIT_V
#undef PG8_WAIT_L
#undef PG8_BAR
#undef PG8_SCHED
}
}

constexpr int NWAVES = 8, NTHR = 512;
constexpr int DM = 2048, NTOK = 8192, NCTX = 4096, DFF = 8192, NLAYER = 4, NMODC = 12288;
constexpr float RMS_EPS = 1e-6f;
constexpr float LOG2E = 1.4426950408889634f;

constexpr size_t MiB = 1u << 20;
constexpr size_t WS_CTL = 0, CTL_ZERO_BYTES = 1 * MiB;
constexpr size_t WS_ROPE = 1 * MiB;
constexpr size_t WS_MOD = 2 * MiB;
constexpr size_t WS_MODP = 4 * MiB;
constexpr size_t WS_GATES = 12 * MiB;
constexpr size_t WS_W = 16 * MiB;
constexpr size_t W_AIN = WS_W, W_AOUT = W_AIN + 24 * MiB, W_BIN = W_AOUT + 8 * MiB, W_BOUT = W_BIN + 24 * MiB;
constexpr size_t W_CIN = W_BOUT + 8 * MiB, W_COUT = W_CIN + 24 * MiB, W_DIN = W_COUT + 8 * MiB, W_DOUT = W_DIN + 12 * MiB;
constexpr size_t W_FF1 = W_DOUT + 8 * MiB, W_FF2 = W_FF1 + 128 * MiB;
constexpr size_t WS_H = W_FF2 + 128 * MiB;
constexpr size_t WS_QKV = WS_H + 32 * MiB;
constexpr size_t WS_O = WS_QKV + 96 * MiB;
constexpr size_t WS_Y = WS_O + 32 * MiB;
constexpr size_t WS_U = WS_Y + 64 * MiB;
constexpr size_t WS_CAK = WS_U + 128 * MiB, WS_CAV = WS_CAK + 8 * MiB, WS_CCK = WS_CAV + 8 * MiB, WS_CCV = WS_CCK + 8 * MiB;
constexpr size_t WS_CDK = WS_CCV + 8 * MiB, WS_CDV = WS_CDK + 2 * MiB, WS_SC = WS_CDV + 2 * MiB;
constexpr size_t WS_END = WS_SC + 4 * MiB;
constexpr int CW_BAR = 4096;

constexpr size_t O_YP = 0, O_AK = 16777216, O_AV = 25165824, O_BC = 33554432, O_BN = 41943040, O_BM = 41975808, O_CK = 41976064, O_CV = 50364672, O_DK = 58753280, O_DV = 60850432, O_END = 62947584;

constexpr int LDS_PHASE_BYTES = 162816;
constexpr int MISC_OFF = LDS_PHASE_BYTES;
constexpr int LDS_BYTES = LDS_PHASE_BYTES + 256;

#define LAS __attribute__((address_space(3)))
#define DI __device__ __forceinline__
typedef unsigned short bf16;
typedef short bf16x8 __attribute__((ext_vector_type(8)));
typedef short s16x4 __attribute__((ext_vector_type(4)));
typedef float f32x16 __attribute__((ext_vector_type(16)));
typedef float f32x4 __attribute__((ext_vector_type(4)));
typedef float f32x2 __attribute__((ext_vector_type(2)));
typedef unsigned u32x4 __attribute__((ext_vector_type(4)));
typedef unsigned u32x2 __attribute__((ext_vector_type(2)));
typedef __bf16 bf16x2_t __attribute__((ext_vector_type(2)));
typedef LAS char* ldsp;

DI unsigned pk2(float lo, float hi) { f32x2 v = {lo, hi}; bf16x2_t b = __builtin_convertvector(v, bf16x2_t); return __builtin_bit_cast(unsigned, b); }
DI float bf2f(unsigned short v) { return __uint_as_float(((unsigned)v) << 16); }
DI float bflo(unsigned w) { return __uint_as_float(w << 16); }
DI float bfhi(unsigned w) { return __uint_as_float(w & 0xffff0000u); }
DI float ex2(float x) { return __builtin_amdgcn_exp2f(x); }
DI float wave_sum(float v) {
#pragma unroll
    for (int o = 1; o < 64; o <<= 1) v += __shfl_xor(v, o);
    return v;
}
DI float hmax(float x) { auto rr = __builtin_amdgcn_permlane32_swap(__float_as_uint(x), __float_as_uint(x), false, false); return fmaxf(__uint_as_float(rr[0]), __uint_as_float(rr[1])); }
DI float hsum(float x) { auto rr = __builtin_amdgcn_permlane32_swap(__float_as_uint(x), __float_as_uint(x), false, false); return __uint_as_float(rr[0]) + __uint_as_float(rr[1]); }
DI int crow(int r, int hi) { return (r & 3) + 8 * (r >> 2) + 4 * hi; }

#define XB_TMO      128
#define XB_XCNT(j)  (256  + 64 * (j))
#define XB_XSUB(j)  (1280 + 64 * (j))
#define XB_XGEN(j)  (2304 + 64 * (j))
#define XB_TOP      3328
#define XB_TOPGEN   3392
#define XCD_BAR_WORDS 3456
#define XB_SPIN_CAP (1u << 18)
__device__ __forceinline__ unsigned xb_ld(unsigned* p)              { return __hip_atomic_load(p, __ATOMIC_RELAXED, __HIP_MEMORY_SCOPE_AGENT); }
__device__ __forceinline__ unsigned xb_add(unsigned* p, unsigned v) { return __hip_atomic_fetch_add(p, v, __ATOMIC_RELAXED, __HIP_MEMORY_SCOPE_AGENT); }
__device__ __forceinline__ unsigned xb_xcc_id() { return (unsigned)__builtin_amdgcn_s_getreg((3 << 11) | 20) & 0xFu; }
#define XB_SPIN(cond, bar) do { unsigned _sp = 0; while (cond) { __builtin_amdgcn_s_sleep(1); \
    if ((++_sp & 255u) == 0u) { if (xb_ld(&(bar)[XB_TMO])) break; if (_sp > XB_SPIN_CAP) { atomicAdd(&(bar)[XB_TMO], 1u); break; } } } } while (0)
struct XcdBarrier { unsigned* bar; unsigned x; volatile LAS unsigned* st; };
__device__ __forceinline__ XcdBarrier xcd_barrier_post(unsigned* bar, volatile LAS unsigned* st) {
    XcdBarrier b; b.bar = bar; b.x = xb_xcc_id(); b.st = st;
    if (threadIdx.x == 0) (void)xb_add(&bar[XB_XCNT(b.x)], 1u);
    return b;
}
__device__ __forceinline__ void xcd_barrier_complete(unsigned* bar, unsigned x, unsigned& nloc, unsigned& nx) {
    const unsigned G = gridDim.x * gridDim.y * gridDim.z;
    unsigned sum, cnt, mine, sp = 0u;
    for (;;) {
        sum = 0u; cnt = 0u; mine = 0u;
#pragma unroll
        for (unsigned j = 0; j < 16; ++j) { const unsigned c = xb_ld(&bar[XB_XCNT(j)]); sum += c; cnt += (c > 0u) ? 1u : 0u; mine = (j == x) ? c : mine; }
        if (sum == G) break;
        __builtin_amdgcn_s_sleep(1);
        if ((++sp & 255u) == 0u) { if (xb_ld(&bar[XB_TMO])) break; if (sp > XB_SPIN_CAP) { atomicAdd(&bar[XB_TMO], 1u); break; } }
    }
    nloc = mine > 0u ? mine : 1u; nx = cnt > 0u ? cnt : 1u;
}
__device__ __forceinline__ void xcd_barrier(const XcdBarrier& b) {
    asm volatile("s_waitcnt vmcnt(0)" ::: "memory");
    __syncthreads();
    if (threadIdx.x == 0) {
        unsigned* bar = b.bar;
        __builtin_amdgcn_s_waitcnt(0);
        unsigned nloc = b.st[0], nx = b.st[1];
        if (nloc == 0u) { xcd_barrier_complete(bar, b.x, nloc, nx); b.st[0] = nloc; b.st[1] = nx; }
        const unsigned old = xb_add(&bar[XB_XSUB(b.x)], 1u);
        const unsigned gen = old / nloc;
        if (old + 1u == (gen + 1u) * nloc) {
            __builtin_amdgcn_fence(__ATOMIC_RELEASE, "agent");
            asm volatile("s_waitcnt vmcnt(0)" ::: "memory");
            const unsigned og = xb_add(&bar[XB_TOP], 1u);
            const unsigned tg = og / nx;
            if (og + 1u == (tg + 1u) * nx) xb_add(&bar[XB_TOPGEN], 1u);
            else XB_SPIN(xb_ld(&bar[XB_TOPGEN]) == tg, bar);
            __builtin_amdgcn_fence(__ATOMIC_ACQUIRE, "agent");
            xb_add(&bar[XB_XGEN(b.x)], 1u);
            asm volatile("s_waitcnt vmcnt(0)" ::: "memory");
        } else {
            XB_SPIN(xb_ld(&bar[XB_XGEN(b.x)]) == gen, bar);
            __builtin_amdgcn_fence(__ATOMIC_ACQUIRE, "agent");
            asm volatile("s_waitcnt vmcnt(0)" ::: "memory");
        }
    }
    __syncthreads();
}

struct Args { const float* in[32]; float* out; unsigned char* ws; int ph_lo, ph_hi; };

DI void transpose_item(const float* W, int K, int N, int ld, bf16* WT, LAS float* scr, int item, int lane) {
    const int nblk = N / 32, kb = item / nblk, nb = item % nblk, k0 = 64 * kb, n0 = 32 * nb;
    float v[32];
#pragma unroll
    for (int i = 0; i < 32; ++i) { const int kk = 2 * i + (lane >> 5); v[i] = W[(size_t)(k0 + kk) * ld + n0 + (lane & 31)]; }
#pragma unroll
    for (int i = 0; i < 32; ++i) { const int kk = 2 * i + (lane >> 5); scr[kk * 33 + (lane & 31)] = v[i]; }
    asm volatile("s_waitcnt lgkmcnt(0)" ::: "memory");
    const int c = lane & 7;
#pragma unroll
    for (int j = 0; j < 4; ++j) { const int n = (lane >> 3) + 8 * j; const LAS float* s = scr + (8 * c) * 33 + n;
        u32x4 o; o.x = pk2(s[0 * 33], s[1 * 33]); o.y = pk2(s[2 * 33], s[3 * 33]); o.z = pk2(s[4 * 33], s[5 * 33]); o.w = pk2(s[6 * 33], s[7 * 33]);
        *(u32x4*)(WT + (size_t)(n0 + n) * K + k0 + 8 * c) = o; }
    asm volatile("s_waitcnt lgkmcnt(0)" ::: "memory");
}
DI void cvt_flat(const float* src, bf16* dst, size_t n8, size_t gtid, size_t nthr) {
    for (size_t i = gtid; i < n8; i += nthr) { const f32x4 a = *(const f32x4*)(src + i * 8), b = *(const f32x4*)(src + i * 8 + 4);
        u32x4 o; o.x = pk2(a[0], a[1]); o.y = pk2(a[2], a[3]); o.z = pk2(b[0], b[1]); o.w = pk2(b[2], b[3]); *(u32x4*)(dst + i * 8) = o; }
}
DI float silu(float x) { return x / (1.f + __expf(-x)); }

DI void p0a_prologue(const Args& A, ldsp lds, int G, int bid, int tid) {
    const int lane = tid & 63, wave = tid >> 6;
    unsigned char* ws = A.ws;
    const int gw = bid * NWAVES + wave, NGW = G * NWAVES;
    LAS float* scr = (LAS float*)(lds + wave * 16384);
    constexpr int I_IN = (DM / 64) * (6144 / 32), I_OUT = (DM / 64) * (DM / 32), I_DIN = (DM / 64) * (3072 / 32), I_F1 = (DM / 64) * (DFF / 32), I_F2 = (DFF / 64) * (DM / 32);
    constexpr int NITEMS = 3 * I_IN + 4 * I_OUT + I_DIN + 4 * I_F1 + 4 * I_F2;
    for (int it = gw; it < NITEMS; it += NGW) {
        int r = it;
        if (r < I_IN) { transpose_item(A.in[18], DM, 6144, 6144, (bf16*)(ws + W_AIN), scr, r, lane); continue; } r -= I_IN;
        if (r < I_OUT) { transpose_item(A.in[19], DM, DM, DM, (bf16*)(ws + W_AOUT), scr, r, lane); continue; } r -= I_OUT;
        if (r < I_IN) { transpose_item(A.in[22], DM, 6144, 6176, (bf16*)(ws + W_BIN), scr, r, lane); continue; } r -= I_IN;
        if (r < I_OUT) { transpose_item(A.in[24], DM, DM, DM, (bf16*)(ws + W_BOUT), scr, r, lane); continue; } r -= I_OUT;
        if (r < I_IN) { transpose_item(A.in[26], DM, 6144, 6144, (bf16*)(ws + W_CIN), scr, r, lane); continue; } r -= I_IN;
        if (r < I_OUT) { transpose_item(A.in[27], DM, DM, DM, (bf16*)(ws + W_COUT), scr, r, lane); continue; } r -= I_OUT;
        if (r < I_DIN) { transpose_item(A.in[29], DM, 3072, 3072, (bf16*)(ws + W_DIN), scr, r, lane); continue; } r -= I_DIN;
        if (r < I_OUT) { transpose_item(A.in[30], DM, DM, DM, (bf16*)(ws + W_DOUT), scr, r, lane); continue; } r -= I_OUT;
        if (r < 4 * I_F1) { const int L = r / I_F1; r -= L * I_F1;
            transpose_item(A.in[16] + (size_t)L * DM * DFF, DM, DFF, DFF, (bf16*)(ws + W_FF1) + (size_t)L * DM * DFF, scr, r, lane); continue; } r -= 4 * I_F1;
        { const int L = r / I_F2; r -= L * I_F2;
            transpose_item(A.in[17] + (size_t)L * DM * DFF, DFF, DM, DM, (bf16*)(ws + W_FF2) + (size_t)L * DM * DFF, scr, r, lane); }
    }
    const size_t gtid = (size_t)bid * NTHR + tid, nthr = (size_t)G * NTHR;
    cvt_flat(A.in[2], (bf16*)(ws + WS_CAK), (size_t)4 * 512 * 2048 / 8, gtid, nthr);
    cvt_flat(A.in[3], (bf16*)(ws + WS_CAV), (size_t)4 * 512 * 2048 / 8, gtid, nthr);
    cvt_flat(A.in[7], (bf16*)(ws + WS_CCK), (size_t)4 * 512 * 2048 / 8, gtid, nthr);
    cvt_flat(A.in[8], (bf16*)(ws + WS_CCV), (size_t)4 * 512 * 2048 / 8, gtid, nthr);
    cvt_flat(A.in[9], (bf16*)(ws + WS_CDK), (size_t)4 * 512 * 512 / 8, gtid, nthr);
    cvt_flat(A.in[10], (bf16*)(ws + WS_CDV), (size_t)4 * 512 * 512 / 8, gtid, nthr);
    cvt_flat(A.in[4], (bf16*)(ws + WS_SC), (size_t)4 * 2 * 8 * 256 * 128 / 8, gtid, nthr);
    if (gtid < 1024) {
        const int pos = (int)gtid >> 4, i = (int)gtid & 15;
        double inv = 1.0; for (int k = 0; k < i; ++k) inv *= 0.5623413251903491;
        const double rev = (double)pos * inv * 0.15915494309189535;
        const double fr = rev - floor(rev);
        float* rt = (float*)(ws + WS_ROPE);
        rt[gtid * 2] = __builtin_amdgcn_cosf((float)fr); rt[gtid * 2 + 1] = __builtin_amdgcn_sinf((float)fr);
    }
    float* modp = (float*)(ws + WS_MODP);
    for (int un = gw; un < 4 * 48 * 8; un += NGW) {
        const int L = un / 384, rem = un % 384, cb = rem >> 3, ks = rem & 7;
        const float* wm = A.in[13] + ((size_t)L * DM + ks * 256) * NMODC + cb * 256 + lane * 4;
        f32x4 acc[5];
#pragma unroll
        for (int c = 0; c < 5; ++c) acc[c] = (f32x4){0.f, 0.f, 0.f, 0.f};
#pragma unroll 8
        for (int k = 0; k < 256; ++k) {
            const f32x4 w = *(const f32x4*)(wm + (size_t)k * NMODC);
            const int kk = ks * 256 + k;
            const float s0 = silu(A.in[12][kk]);
            acc[0] += w * s0;
#pragma unroll
            for (int c = 1; c < 5; ++c) { const float s = silu(A.in[11][(c - 1) * DM + kk]); acc[c] += w * s; }
        }
#pragma unroll
        for (int c = 0; c < 5; ++c) *(f32x4*)(modp + ((size_t)(L * 8 + ks) * 5 + c) * NMODC + cb * 256 + lane * 4) = acc[c];
    }
}
DI void p0b_modreduce(const Args& A, int G, int bid, int tid) {
    const float* modp = (const float*)(A.ws + WS_MODP); float* mod = (float*)(A.ws + WS_MOD);
    for (int i = bid * NTHR + tid; i < 4 * 5 * NMODC; i += G * NTHR) {
        const int L = i / (5 * NMODC), rem = i % (5 * NMODC), c = rem / NMODC, col = rem % NMODC;
        float s = A.in[14][L * NMODC + col];
#pragma unroll
        for (int ks = 0; ks < 8; ++ks) s += modp[((size_t)(L * 8 + ks) * 5 + c) * NMODC + col];
        mod[i] = s;
    }
}

struct RowP {
    const bf16* Y;
    int mod_gate;
    int Lg;
    int gpost;
    int has_next;
    int Ln;
    int gpre;
    int mod_shift;
    int do_gates;
    int dry;
};
DI void row_load(const Args& A, const RowP& P, int r, int lane, f32x4 (&x)[8], u32x2 (&yw)[8]) {
    const float* src = P.Y == nullptr ? (r < NCTX ? A.in[0] + (size_t)r * DM : A.in[1] + (size_t)(r - NCTX) * DM) : A.out + (size_t)r * DM;
#pragma unroll
    for (int j = 0; j < 8; ++j) x[j] = *(const f32x4*)(src + 4 * lane + 256 * j);
    if (P.Y != nullptr) {
#pragma unroll
        for (int j = 0; j < 8; ++j) yw[j] = *(const u32x2*)(P.Y + (size_t)r * DM + 4 * lane + 256 * j);
    }
}
DI void row_proc(const Args& A, const RowP& P, ldsp lds, int r, int lane, int wave, f32x4 (&x)[8], const u32x2 (&yw)[8]) {
    bf16* H = (bf16*)(A.ws + WS_H);
    float* Xw = P.dry ? (float*)(A.ws + WS_U) : A.out; bf16* Hw = P.dry ? (bf16*)(A.ws + WS_U + 64 * MiB) : H;
    const float* mod = (const float*)(A.ws + WS_MOD); const float* gn = A.in[15];
    const int cond = r < NCTX ? 0 : 1 + ((r - NCTX) >> 10);
    if (P.Y != nullptr) {
        f32x4 y[8]; float ss = 0.f;
#pragma unroll
        for (int j = 0; j < 8; ++j) { y[j] = (f32x4){bflo(yw[j].x), bfhi(yw[j].x), bflo(yw[j].y), bfhi(yw[j].y)}; ss += (y[j][0] * y[j][0] + y[j][1] * y[j][1]) + (y[j][2] * y[j][2] + y[j][3] * y[j][3]); }
        const float rs = 1.0f / sqrtf(wave_sum(ss) * (1.f / DM) + RMS_EPS);
        const float* gate = mod + ((size_t)(P.Lg * 5 + cond) * 6 + P.mod_gate) * DM; const float* gp = gn + (size_t)P.gpost * DM;
#pragma unroll
        for (int j = 0; j < 8; ++j) { const f32x4 gt = *(const f32x4*)(gate + 4 * lane + 256 * j), gg = *(const f32x4*)(gp + 4 * lane + 256 * j);
            x[j] = x[j] + gt * (y[j] * rs * gg); }
    }
#pragma unroll
    for (int j = 0; j < 8; ++j) *(f32x4*)(Xw + (size_t)r * DM + 4 * lane + 256 * j) = x[j];
    if (P.has_next) {
        float ss = 0.f;
#pragma unroll
        for (int j = 0; j < 8; ++j) ss += (x[j][0] * x[j][0] + x[j][1] * x[j][1]) + (x[j][2] * x[j][2] + x[j][3] * x[j][3]);
        const float rs = 1.0f / sqrtf(wave_sum(ss) * (1.f / DM) + RMS_EPS);
        const float* sh = mod + ((size_t)(P.Ln * 5 + cond) * 6 + P.mod_shift) * DM; const float* sc = sh + DM; const float* gp = gn + (size_t)P.gpre * DM;
#pragma unroll
        for (int j = 0; j < 8; ++j) { const f32x4 gg = *(const f32x4*)(gp + 4 * lane + 256 * j), s1 = *(const f32x4*)(sc + 4 * lane + 256 * j), s0 = *(const f32x4*)(sh + 4 * lane + 256 * j);
            x[j] = (x[j] * rs * gg) * (1.0f + s1) + s0;
            u32x2 o; o.x = pk2(x[j][0], x[j][1]); o.y = pk2(x[j][2], x[j][3]);
            *(u32x2*)(Hw + (size_t)r * DM + 4 * lane + 256 * j) = o; }
            if (P.do_gates && !P.dry) {
                LAS float* hrow = (LAS float*)(lds + wave * 8192);
#pragma unroll
                for (int j = 0; j < 8; ++j) *(LAS f32x4*)(hrow + 4 * lane + 256 * j) = x[j];
                asm volatile("s_waitcnt lgkmcnt(0)" ::: "memory");
                const float* Wg = A.in[22] + 6144;
                float acc[32];
#pragma unroll
                for (int g = 0; g < 32; ++g) acc[g] = 0.f;
#pragma unroll 2
                for (int i = 0; i < 32; ++i) { const int c = lane + 64 * i; const float hv = hrow[c]; const float* wr = Wg + (size_t)c * 6176;
#pragma unroll
                    for (int q = 0; q < 8; ++q) { const f32x4 w = *(const f32x4*)(wr + 4 * q);
                        acc[4 * q] += hv * w[0]; acc[4 * q + 1] += hv * w[1]; acc[4 * q + 2] += hv * w[2]; acc[4 * q + 3] += hv * w[3]; } }
                float mine = 0.f;
#pragma unroll
                for (int g = 0; g < 32; ++g) { const float sg = wave_sum(acc[g]); mine = (lane == g) ? sg : mine; }
                if (lane < 32) ((float*)(A.ws + WS_GATES))[(size_t)r * 32 + lane] = mine + A.in[23][lane];
                asm volatile("s_waitcnt lgkmcnt(0)" ::: "memory");
            }
    }
}
DI void row_phase(const Args& A, const RowP& P, ldsp lds, int G, int bid, int tid) {
    const int lane = tid & 63, wave = tid >> 6;
    const int gw = bid * NWAVES + wave, NGW = G * NWAVES;
    for (int r = gw; r < NTOK; r += 2 * NGW) {
        f32x4 xa[8], xb[8]; u32x2 ya[8], yb[8];
        const int r2 = r + NGW;
        row_load(A, P, r, lane, xa, ya);
        if (r2 < NTOK) row_load(A, P, r2, lane, xb, yb);
        row_proc(A, P, lds, r, lane, wave, xa, ya);
        if (r2 < NTOK) row_proc(A, P, lds, r2, lane, wave, xb, yb);
    }
}

typedef short v4i16_t __attribute__((ext_vector_type(4)));
DI s16x4 tr_read(ldsp p) { return __builtin_bit_cast(s16x4, __builtin_amdgcn_ds_read_tr16_b64_v4i16((LAS v4i16_t*)p)); }
template <int OFF> DI s16x4 tr_asm(unsigned addr) { s16x4 r; asm volatile("ds_read_b64_tr_b16 %0, %1 offset:%2" : "=&v"(r) : "v"(addr), "i"(OFF) : "memory"); return r; }
#define MFMA32(a, b, c) __builtin_amdgcn_mfma_f32_32x32x16_bf16((a), (b), (c), 0, 0, 0)

template <int NS> DI void qk_tile(f32x16& s, ldsp kaddr, const bf16x8 (&qr)[NS]) {
#pragma unroll
    for (int i = 0; i < 16; ++i) s[i] = 0.f;
#pragma unroll
    for (int d0 = 0; d0 < NS; ++d0) { const bf16x8 a = *(const LAS bf16x8*)(kaddr + 32 * d0); s = MFMA32(a, qr[d0], s); }
}
template <int NS> DI void qk_tile_lq(f32x16& s, ldsp kaddr, ldsp qaddr) {
#pragma unroll
    for (int i = 0; i < 16; ++i) s[i] = 0.f;
#pragma unroll
    for (int d0 = 0; d0 < NS; ++d0) { const bf16x8 a = *(const LAS bf16x8*)(kaddr + 32 * d0); const bf16x8 b = *(const LAS bf16x8*)(qaddr + 32 * d0); s = MFMA32(a, b, s); }
}
template <int S> DI bf16x8 pack8(const f32x16& p) {
    u32x4 w; w.x = pk2(p[8 * S + 0], p[8 * S + 1]); w.y = pk2(p[8 * S + 2], p[8 * S + 3]); w.z = pk2(p[8 * S + 4], p[8 * S + 5]); w.w = pk2(p[8 * S + 6], p[8 * S + 7]);
    return __builtin_bit_cast(bf16x8, w);
}
template <int ND> DI void pv_tile(f32x16 (&o)[ND], ldsp vaddr, int pvb, bf16x8 p0, bf16x8 p1) {
#pragma unroll
    for (int d0 = 0; d0 < ND; ++d0) {
        const s16x4 l0 = tr_read(vaddr + 64 * d0), h0 = tr_read(vaddr + 8 * pvb + 64 * d0);
        const s16x4 l1 = tr_read(vaddr + 16 * pvb + 64 * d0), h1 = tr_read(vaddr + 24 * pvb + 64 * d0);
        const bf16x8 a0 = {l0[0], l0[1], l0[2], l0[3], h0[0], h0[1], h0[2], h0[3]};
        const bf16x8 a1 = {l1[0], l1[1], l1[2], l1[3], h1[0], h1[1], h1[2], h1[3]};
        o[d0] = MFMA32(a0, p0, o[d0]);
        o[d0] = MFMA32(a1, p1, o[d0]);
    }
}
template <int NC> DI void stage_ld(bf16x8 (&r)[NC / 64], const bf16* src, size_t gs, int tid) {
#pragma unroll
    for (int i = 0; i < NC / 64; ++i) { const int idx = tid + NTHR * i, row = idx / (NC / 8), c8 = idx % (NC / 8); r[i] = *(const bf16x8*)(src + (size_t)row * gs + c8 * 8); }
}
template <int NC> DI void stage_st(const bf16x8 (&r)[NC / 64], ldsp dst, int pb, int tid) {
#pragma unroll
    for (int i = 0; i < NC / 64; ++i) { const int idx = tid + NTHR * i, row = idx / (NC / 8), c8 = idx % (NC / 8); *(LAS bf16x8*)(dst + row * pb + c8 * 16) = r[i]; }
}

template <int RB> DI int fK(int row) { return RB == 128 ? ((row >> 1) & 7) : (row & 15); }
template <int RB> DI int fV(int row) { return RB == 128 ? (((row >> 1) & 1) << 2) : ((row & 3) << 2); }
template <int RB, bool ISV> DI void dma_tile(ldsp dst, const bf16* src, size_t gs, int wave, int lane) {
    constexpr int NI = 64 * RB / 1024 / 8, SPR = RB / 16, RPP = 1024 / RB;
    const int pos = wave * 64 + lane, row = pos / SPR, sl = pos % SPR, g = sl ^ (ISV ? fV<RB>(row) : fK<RB>(row));
    const bf16* lp = src + (size_t)row * gs + g * 8;
#pragma unroll
    for (int i = 0; i < NI; ++i)
        __builtin_amdgcn_global_load_lds((const unsigned*)(lp + (size_t)(8 * i * RPP) * gs), (LAS unsigned*)(dst + (wave + 8 * i) * 1024), 16, 0, 0);
}
#define VM_WAIT_N(n) asm volatile("s_waitcnt vmcnt(" #n ")" ::: "memory")
template <int PIECES> DI void wait_chunks(int rem) {
    if (rem >= 2) { if constexpr (PIECES == 2) VM_WAIT_N(4); else if constexpr (PIECES == 4) VM_WAIT_N(8); else VM_WAIT_N(12); }
    else if (rem == 1) { if constexpr (PIECES == 2) VM_WAIT_N(2); else if constexpr (PIECES == 4) VM_WAIT_N(4); else VM_WAIT_N(6); }
    else VM_WAIT_N(0);
}

template <int DQK, int KW, int DV, class Pol>
DI void attn_loop(ldsp lds, const Pol& P, const bf16x8 (&qr)[DQK / 16], f32x16 (&o)[DV / 32], float& m, float& l, int tid) {
    constexpr int RBK = KW * 2, RBV = DV * 2, KBYTES = 64 * RBK, VBYTES = 64 * RBV, BUF = KBYTES + VBYTES, NS = 4, PD = 3;
    constexpr int PIECES = (KBYTES + VBYTES) / 8192;
    const int lane = tid & 63, wave = __builtin_amdgcn_readfirstlane(tid >> 6), r32 = lane & 31, h2 = lane >> 5, i16 = lane & 15, tq = i16 >> 2, tp = i16 & 3, blk = (lane >> 4) & 1;
    const int kx = fK<RBK>(r32), kg0 = P.kcol / 8 + h2;
    const int krow = r32 * RBK;
    const int vbase = (4 * h2 + tq) * RBV + 32 * blk + 8 * tp;
    const int vx = RBV == 128 ? (tq >> 1) : tq;
    const int n = P.nchunks;
    asm volatile("s_waitcnt vmcnt(0) lgkmcnt(0)" ::: "memory");
#pragma unroll
    for (int k = 0; k < PD; ++k) if (k < n) { const bf16 *kp, *vp; size_t st; P.src(k, kp, vp, st); ldsp sb = lds + k * BUF; dma_tile<RBK, false>(sb, kp, st, wave, lane); dma_tile<RBV, true>(sb + KBYTES, vp, st, wave, lane); }
    for (int c = 0; c < n; ++c) {
        wait_chunks<PIECES>(n - 1 - c < PD - 1 ? n - 1 - c : PD - 1);
        __builtin_amdgcn_s_barrier(); asm volatile("" ::: "memory");
        if (c + PD < n) { const bf16 *kp, *vp; size_t st; P.src(c + PD, kp, vp, st); ldsp sb = lds + ((c + PD) & (NS - 1)) * BUF; dma_tile<RBK, false>(sb, kp, st, wave, lane); dma_tile<RBV, true>(sb + KBYTES, vp, st, wave, lane); }
        ldsp kb = lds + (c & (NS - 1)) * BUF; ldsp vb = kb + KBYTES;
        if (P.active(c)) {
#pragma unroll
            for (int kt = 0; kt < 2; ++kt) {
                f32x16 s0;
#pragma unroll
                for (int i = 0; i < 16; ++i) s0[i] = 0.f;
#pragma unroll
                for (int d0 = 0; d0 < DQK / 16; ++d0) { const bf16x8 a = *(const LAS bf16x8*)(kb + 32 * kt * RBK + krow + (((kg0 + 2 * d0) ^ kx) << 4)); s0 = MFMA32(a, qr[d0], s0); }
                P.fix(c, kt, s0);
                float mx = s0[0];
#pragma unroll
                for (int r = 1; r < 16; ++r) mx = fmaxf(mx, s0[r]);
                mx = hmax(mx) * P.sc2;
                if (!__all(mx - m <= 8.0f)) {
                    const float mn = fmaxf(m, mx), alpha = ex2(m - mn); m = mn; l *= alpha;
#pragma unroll
                    for (int d0 = 0; d0 < DV / 32; ++d0)
#pragma unroll
                        for (int r = 0; r < 16; ++r) o[d0][r] *= alpha;
                }
                float ps = 0.f;
#pragma unroll
                for (int r = 0; r < 16; ++r) { s0[r] = ex2(fmaf(s0[r], P.sc2, -m)); ps += s0[r]; }
                l += hsum(ps);
                const bf16x8 p0 = pack8<0>(s0), p1 = pack8<1>(s0);
                const unsigned va0 = (unsigned)(__UINTPTR_TYPE__)vb + (unsigned)((32 * kt) * RBV + vbase);
#pragma unroll
                for (int dp = 0; dp < DV / 64; ++dp) {
                    const unsigned a = va0 + 64 * ((2 * dp) ^ vx), b = va0 + 64 * ((2 * dp + 1) ^ vx);
                    const s16x4 l0 = tr_asm<0>(a), h0 = tr_asm<8 * RBV>(a), l1 = tr_asm<16 * RBV>(a), h1 = tr_asm<24 * RBV>(a);
                    const s16x4 m0 = tr_asm<0>(b), n0 = tr_asm<8 * RBV>(b), m1 = tr_asm<16 * RBV>(b), n1 = tr_asm<24 * RBV>(b);
                    asm volatile("s_waitcnt lgkmcnt(0)" ::: "memory"); __builtin_amdgcn_sched_barrier(0);
                    const bf16x8 a0 = {l0[0], l0[1], l0[2], l0[3], h0[0], h0[1], h0[2], h0[3]};
                    const bf16x8 a1 = {l1[0], l1[1], l1[2], l1[3], h1[0], h1[1], h1[2], h1[3]};
                    const bf16x8 b0 = {m0[0], m0[1], m0[2], m0[3], n0[0], n0[1], n0[2], n0[3]};
                    const bf16x8 b1 = {m1[0], m1[1], m1[2], m1[3], n1[0], n1[1], n1[2], n1[3]};
                    o[2 * dp] = MFMA32(a0, p0, o[2 * dp]);
                    o[2 * dp + 1] = MFMA32(b0, p0, o[2 * dp + 1]);
                    o[2 * dp] = MFMA32(a1, p1, o[2 * dp]);
                    o[2 * dp + 1] = MFMA32(b1, p1, o[2 * dp + 1]);
                }
            }
        }
    }
    asm volatile("s_waitcnt lgkmcnt(0)" ::: "memory"); __builtin_amdgcn_s_barrier(); asm volatile("" ::: "memory");
}
template <int ND> DI void store_ot(const f32x16 (&o)[ND], float inv, bf16* orow, int h2) {
#pragma unroll
    for (int d0 = 0; d0 < ND; ++d0)
#pragma unroll
        for (int g = 0; g < 4; ++g) { u32x2 w; w.x = pk2(o[d0][4 * g] * inv, o[d0][4 * g + 1] * inv); w.y = pk2(o[d0][4 * g + 2] * inv, o[d0][4 * g + 3] * inv);
            *(u32x2*)(orow + 32 * d0 + 8 * g + 4 * h2) = w; }
}

struct PolA {
    static constexpr float sc2 = 0.125f * LOG2E;
    int nchunks, kcol; const bf16* QKV; const bf16* CK; const bf16* CV; int b, h, latent;
    DI void src(int c, const bf16*& kp, const bf16*& vp, size_t& st) const {
        if (latent && c < 8) { const size_t off = ((size_t)(b * 512 + 64 * c) * 16 + h) * 128; kp = CK + off; vp = CV + off; st = 2048; }
        else { const int row = latent ? NCTX + b * 1024 + 64 * (c - 8) : b * 256 + 64 * c; kp = QKV + (size_t)row * 6144 + 2048 + h * 128; vp = kp + 2048; st = 6144; }
    }
    DI bool active(int) const { return true; }
    DI void fix(int, int, f32x16&) const {}
};
DI void phaseA(const Args& A, ldsp lds, int G, int bid, int tid) {
    const int lane = tid & 63, wave = tid >> 6, r32 = lane & 31, h2 = lane >> 5, j = wave >> 2, wq = wave & 3;
    const bf16* QKV = (const bf16*)(A.ws + WS_QKV); bf16* O = (bf16*)(A.ws + WS_O);
    const float lam_init = 0.2f;
    LAS float* xb = (LAS float*)lds;
    for (int u = bid; u < 1024; u += G) {
        PolA P; P.QKV = QKV; P.CK = (const bf16*)(A.ws + WS_CAK); P.CV = (const bf16*)(A.ws + WS_CAV); P.kcol = 64 * j;
        int rowbase;
        if (u < 512) { const int uu = (G == 256) ? ((((u >> 8) * 128 + (bid & 7) * 16 + (bid >> 4)) << 1) | ((bid >> 3) & 1)) : u;
            P.latent = 0; P.b = uu >> 5; P.h = (uu >> 1) & 15; P.nchunks = 4; rowbase = P.b * 256 + (uu & 1) * 128; }
        else { const int v0 = u - 512; const int v = (G == 256) ? ((((v0 >> 8) * 32 + (bid & 7) * 4 + (bid >> 6)) << 3) | ((bid >> 3) & 7)) : v0;
            P.latent = 1; P.b = v >> 7; P.h = (v >> 3) & 15; P.nchunks = 24; rowbase = NCTX + P.b * 1024 + (v & 7) * 128; }
        const int row = rowbase + 32 * wq + r32;
        bf16x8 qr[4];
#pragma unroll
        for (int d0 = 0; d0 < 4; ++d0) qr[d0] = *(const bf16x8*)(QKV + (size_t)row * 6144 + P.h * 128 + j * 64 + 16 * d0 + 8 * h2);
        f32x16 o[4];
#pragma unroll
        for (int d0 = 0; d0 < 4; ++d0)
#pragma unroll
            for (int r = 0; r < 16; ++r) o[d0][r] = 0.f;
        float m = -1e30f, l = 0.f;
        asm volatile("s_waitcnt vmcnt(0)" ::: "memory");
#pragma unroll
        for (int d0 = 0; d0 < 4; ++d0) asm volatile("" : "+v"(qr[d0]));
        asm volatile("" : "+v"(m));
        attn_loop<64, 128, 128, PolA>(lds, P, qr, o, m, l, tid);
        const float inv = 1.0f / l;
        if (j == 1) {
#pragma unroll
            for (int d0 = 0; d0 < 4; ++d0)
#pragma unroll
                for (int r = 0; r < 16; ++r) xb[((wq * 4 + d0) * 16 + r) * 64 + lane] = o[d0][r] * inv;
        }
        __syncthreads();
        if (j == 0) {
            const float* lp = A.in[20];
            const float d1 = wave_sum(lp[(0 * 16 + P.h) * 64 + lane] * lp[(1 * 16 + P.h) * 64 + lane]);
            const float d2 = wave_sum(lp[(2 * 16 + P.h) * 64 + lane] * lp[(3 * 16 + P.h) * 64 + lane]);
            const float lam = __expf(d1) - __expf(d2) + lam_init;
            float ss = 0.f;
#pragma unroll
            for (int d0 = 0; d0 < 4; ++d0)
#pragma unroll
                for (int r = 0; r < 16; ++r) { const float v = o[d0][r] * inv - lam * xb[((wq * 4 + d0) * 16 + r) * 64 + lane]; o[d0][r] = v; ss += v * v; }
            ss = hsum(ss);
            const float rs = (1.0f / sqrtf(ss * (1.f / 128.f) + RMS_EPS)) * (1.0f - lam_init);
            const float* sub = A.in[21];
#pragma unroll
            for (int d0 = 0; d0 < 4; ++d0)
#pragma unroll
                for (int r = 0; r < 16; ++r) o[d0][r] *= sub[32 * d0 + crow(r, h2)];
            store_ot<4>(o, rs, O + (size_t)row * DM + P.h * 128, h2);
        }
        __syncthreads();
    }
}

struct PolC {
    static constexpr float sc2 = 0.08838834764831845f * LOG2E;
    int nchunks, kcol; const bf16* QKV; const bf16* CK; const bf16* CV; int b, h, latent;
    int nb, krlo, r, r0, qc, cstart; const LAS float* rpb;
    DI void src(int c, const bf16*& kp, const bf16*& vp, size_t& st) const {
        if (latent && c >= nb) { const size_t off = ((size_t)(b * 512 + 64 * (c - nb)) * 16 + h) * 128; kp = CK + off; vp = CV + off; st = 2048; }
        else { const int row = latent ? NCTX + b * 1024 + 64 * (krlo + c) : b * 256 + 64 * c; kp = QKV + (size_t)row * 6144 + 2048 + h * 128; vp = kp + 2048; st = 6144; }
    }
    DI bool active(int c) const { return !latent || c >= nb || (krlo + c >= r0 && krlo + c < r0 + 8); }
    DI void fix(int c, int kt, f32x16& s) const {
        if (latent && c < nb) {
            int h2 = (threadIdx.x >> 5) & 1; asm volatile("" : "+v"(h2));
            const int kr = krlo + c;
            int drow = kr - r + 7; drow = drow < 0 ? 0 : (drow > 14 ? 14 : drow);
#pragma unroll
            for (int rr = 0; rr < 16; ++rr) { const int kc = 32 * kt + crow(rr, h2); const bool ok = (kc >= cstart) && (kc < cstart + 16);
                int dc = kc - qc + 15; dc = dc < 0 ? 0 : (dc > 30 ? 30 : dc);
                const float bias = rpb[drow * 31 + dc];
                s[rr] = ok ? s[rr] + bias : -INFINITY; }
        }
    }
};
DI void phaseC(const Args& A, ldsp lds, int G, int bid, int tid) {
    const int lane = tid & 63, wave = __builtin_amdgcn_readfirstlane(tid >> 6), r32 = lane & 31, h2 = lane >> 5;
    const bf16* QKV = (const bf16*)(A.ws + WS_QKV); bf16* O = (bf16*)(A.ws + WS_O);
    LAS float* rpbL = (LAS float*)(lds + 4 * 32768);
    for (int u = bid; u < 512; u += G) {
        PolC P; P.QKV = QKV; P.CK = (const bf16*)(A.ws + WS_CCK); P.CV = (const bf16*)(A.ws + WS_CCV); P.kcol = 0; P.rpb = rpbL;
        int row;
        if (u < 256) { P.latent = 0; P.b = u >> 4; P.h = u & 15; P.nchunks = 4; row = P.b * 256 + 32 * wave + r32; P.nb = 0; P.krlo = 0; P.r = 0; P.r0 = 0; P.qc = 0; P.cstart = 0; }
        else { const int v0 = u - 256; const int v = (G == 256) ? ((((bid & 7) * 8 + (bid >> 5)) << 2) | ((bid >> 3) & 3)) : v0;
            P.latent = 1; P.b = v >> 6; P.h = (v >> 2) & 15; const int R4 = v & 3;
            const int rlo = 4 * R4, rhi = 4 * R4 + 3;
            const int r0lo = rlo - 4 < 0 ? 0 : (rlo - 4 > 8 ? 8 : rlo - 4), r0hi = rhi - 4 < 0 ? 0 : (rhi - 4 > 8 ? 8 : rhi - 4);
            P.krlo = r0lo; P.nb = r0hi + 8 - r0lo; P.nchunks = P.nb + 8;
            P.r = rlo + (wave >> 1); P.r0 = P.r - 4 < 0 ? 0 : (P.r - 4 > 8 ? 8 : P.r - 4);
            P.qc = 32 * (wave & 1) + r32; P.cstart = P.qc - 8 < 0 ? 0 : (P.qc - 8 > 48 ? 48 : P.qc - 8);
            row = NCTX + P.b * 1024 + P.r * 64 + P.qc;
            for (int i = tid; i < 15 * 31; i += NTHR) rpbL[i] = A.in[28][(size_t)P.h * 465 + i] * 11.313708498984761f;
        }
        bf16x8 qr[8];
#pragma unroll
        for (int d0 = 0; d0 < 8; ++d0) qr[d0] = *(const bf16x8*)(QKV + (size_t)row * 6144 + P.h * 128 + 16 * d0 + 8 * h2);
        f32x16 o[4];
#pragma unroll
        for (int d0 = 0; d0 < 4; ++d0)
#pragma unroll
            for (int r = 0; r < 16; ++r) o[d0][r] = 0.f;
        float m = -1e30f, l = 0.f;
        asm volatile("s_waitcnt vmcnt(0)" ::: "memory");
#pragma unroll
        for (int d0 = 0; d0 < 8; ++d0) asm volatile("" : "+v"(qr[d0]));
        asm volatile("" : "+v"(m));
        attn_loop<128, 128, 128, PolC>(lds, P, qr, o, m, l, tid);
        store_ot<4>(o, 1.0f / l, O + (size_t)row * DM + P.h * 128, h2);
    }
}

struct PolD {
    static constexpr float sc2 = 0.125f * LOG2E;
    int nchunks, kcol; const bf16* QKV; const bf16* CK; const bf16* CV; int b, kvh, latent;
    int nl, kc0, qpos;
    DI void src(int c, const bf16*& kp, const bf16*& vp, size_t& st) const {
        if (latent && c >= nl) { const size_t off = ((size_t)(b * 512 + 64 * (c - nl)) * 8 + kvh) * 64; kp = CK + off; vp = CV + off; st = 512; }
        else { const int row = latent ? NCTX + b * 1024 + 64 * (kc0 + c) : b * 256 + 64 * c; kp = QKV + (size_t)row * 3072 + 2048 + kvh * 64; vp = kp + 512; st = 3072; }
    }
    DI bool active(int) const { return true; }
    DI void fix(int c, int kt, f32x16& s) const {
        if (latent && c < nl) {
            int h2 = (threadIdx.x >> 5) & 1; asm volatile("" : "+v"(h2));
#pragma unroll
            for (int rr = 0; rr < 16; ++rr) { const int kpos = 64 * (kc0 + c) + 32 * kt + crow(rr, h2); const int d = qpos - kpos;
                s[rr] = (d <= 128 && d >= -128) ? s[rr] : -INFINITY; }
        }
    }
};
DI void phaseD(const Args& A, ldsp lds, int G, int bid, int tid) {
    const int lane = tid & 63, wave = tid >> 6, r32 = lane & 31, h2 = lane >> 5, g = wave >> 1, qsub = wave & 1;
    const bf16* QKV = (const bf16*)(A.ws + WS_QKV); bf16* O = (bf16*)(A.ws + WS_O);
    for (int u = bid; u < 1024; u += G) {
        PolD P; P.QKV = QKV; P.CK = (const bf16*)(A.ws + WS_CDK); P.CV = (const bf16*)(A.ws + WS_CDV); P.kcol = 0;
        int row;
        if (u < 512) { const int uu = (G == 256) ? ((((u >> 8) * 64 + (bid & 7) * 8 + (bid >> 5)) << 2) | ((bid >> 3) & 3)) : u;
            P.latent = 0; P.b = uu >> 5; P.kvh = (uu >> 2) & 7; P.nchunks = 4; P.nl = 0; P.kc0 = 0; P.qpos = 0; row = P.b * 256 + 64 * (uu & 3) + 32 * qsub + r32; }
        else { const int v0 = u - 512; const int v = (G == 256) ? ((((v0 >> 8) * 16 + (bid & 7) * 2 + (bid >> 7)) << 4) | ((bid >> 3) & 15)) : v0;
            P.latent = 1; P.b = v >> 7; P.kvh = (v >> 4) & 7; const int qb = v & 15;
            P.kc0 = qb - 2 < 0 ? 0 : qb - 2; const int kc1 = qb + 3 > 15 ? 15 : qb + 3; P.nl = kc1 - P.kc0 + 1; P.nchunks = P.nl + 8;
            P.qpos = 64 * qb + 32 * qsub + r32; row = NCTX + P.b * 1024 + P.qpos; }
        bf16x8 qr[4];
#pragma unroll
        for (int d0 = 0; d0 < 4; ++d0) qr[d0] = *(const bf16x8*)(QKV + (size_t)row * 3072 + P.kvh * 256 + g * 64 + 16 * d0 + 8 * h2);
        f32x16 o[2];
#pragma unroll
        for (int d0 = 0; d0 < 2; ++d0)
#pragma unroll
            for (int r = 0; r < 16; ++r) o[d0][r] = 0.f;
        float m = A.in[31][P.kvh * 4 + g] * LOG2E, l = 1.0f;
        asm volatile("s_waitcnt vmcnt(0)" ::: "memory");
#pragma unroll
        for (int d0 = 0; d0 < 4; ++d0) asm volatile("" : "+v"(qr[d0]));
        asm volatile("" : "+v"(m));
        attn_loop<64, 64, 64, PolD>(lds, P, qr, o, m, l, tid);
        store_ot<2>(o, 1.0f / l, O + (size_t)row * DM + P.kvh * 256 + g * 64, h2);
    }
}

DI float logsigmoid(float x) { return fminf(x, 0.f) - log1pf(expf(-fabsf(x))); }
DI void mlstm_scan(const float* gates, int rowbase, int h, int dir, float m0, int T, LAS float* At, LAS float* Mt, LAS float* Gt, int lane) {
    float cG = 0.f, cM = m0;
#pragma unroll 1
    for (int seg = 0; seg < T; seg += 256) {
        float gi[4], gf[4];
#pragma unroll
        for (int e = 0; e < 4; ++e) { const int p = seg + lane * 4 + e, t = dir ? T - 1 - p : p; const float* gr = gates + (size_t)(rowbase + t) * 32 + dir * 16 + h;
            gi[e] = gr[0]; gf[e] = logsigmoid(gr[8]); }
        float run = 0.f;
#pragma unroll
        for (int e = 0; e < 4; ++e) { run += gf[e]; gf[e] = run; }
        float pre = run;
#pragma unroll
        for (int o = 1; o < 64; o <<= 1) { const float v = __shfl_up(pre, o); if (lane >= o) pre += v; }
        const float tot = __shfl(pre, 63);
        pre = pre - run + cG;
        float mx = -INFINITY;
#pragma unroll
        for (int e = 0; e < 4; ++e) { gf[e] += pre; gi[e] -= gf[e]; mx = fmaxf(mx, gi[e]); }
        float pm = mx;
#pragma unroll
        for (int o = 1; o < 64; o <<= 1) { const float v = __shfl_up(pm, o); if (lane >= o) pm = fmaxf(pm, v); }
        const float allm = __shfl(pm, 63);
        float ex = __shfl_up(pm, 1); if (lane == 0) ex = -INFINITY;
        float rm = fmaxf(cM, ex);
#pragma unroll
        for (int e = 0; e < 4; ++e) { const int p = seg + lane * 4 + e, t = dir ? T - 1 - p : p; rm = fmaxf(rm, gi[e]); At[t] = gi[e]; Mt[t] = rm; Gt[t] = gf[e]; }
        cG += tot; cM = fmaxf(cM, allm);
    }
}

constexpr int B_PKB = 272, B_PVB = 576, B_KBYTES = 64 * B_PKB, B_VBYTES = 64 * B_PVB, B_BUF = B_KBYTES + B_VBYTES;
constexpr int BR_K = 16384, BR_V = 32768, BR_STG = BR_K + BR_V, BR_NS = 3;
constexpr int BL_ET = BR_NS * BR_STG;
constexpr int BL_RC = BL_ET + 8192;
constexpr int BL_AD = BL_RC + 128;
constexpr int BL_MG = BL_AD + 512;
constexpr int BL_SX = BL_MG + 1024;
static_assert(BL_SX + 2048 <= LDS_PHASE_BYTES, "phase B LDS map");

template <int EL> DI void mlstm_scan8(const float* gates, int rowbase, int h, int T, int qb, float m0, ldsp lds, int wave, int lane) {
    const int dir = wave >> 2, sg = wave & 3, SL = 64 * EL;
    LAS float* Et = (LAS float*)(lds + BL_ET) + dir * 1024; LAS float* Rc = (LAS float*)(lds + BL_RC) + dir * 16; LAS float* Ad = (LAS float*)(lds + BL_AD) + dir * 64;
    LAS float* MG = (LAS float*)(lds + BL_MG) + dir * 128; LAS float* sx = (LAS float*)(lds + BL_SX);
    float gi[EL], gf[EL], pmx[EL];
#pragma unroll
    for (int e = 0; e < EL; ++e) { const int p = sg * SL + lane * EL + e, t = dir ? T - 1 - p : p; const float* gr = gates + (size_t)(rowbase + t) * 32 + dir * 16 + h;
        gi[e] = gr[0]; gf[e] = logsigmoid(gr[8]); }
    float run = 0.f;
#pragma unroll
    for (int e = 0; e < EL; ++e) { run += gf[e]; gf[e] = run; }
    float pre = run;
#pragma unroll
    for (int o = 1; o < 64; o <<= 1) { const float v = __shfl_up(pre, o); if (lane >= o) pre += v; }
    const float tot = __shfl(pre, 63);
    pre -= run;
    float mx = -INFINITY;
#pragma unroll
    for (int e = 0; e < EL; ++e) { gf[e] += pre; gi[e] -= gf[e]; mx = fmaxf(mx, gi[e]); pmx[e] = mx; }
    float pm = mx;
#pragma unroll
    for (int o = 1; o < 64; o <<= 1) { const float v = __shfl_up(pm, o); if (lane >= o) pm = fmaxf(pm, v); }
    const float allm = __shfl(pm, 63);
    float ex = __shfl_up(pm, 1); if (lane == 0) ex = -INFINITY;
    if (lane == 0) { sx[wave * 2] = tot; sx[wave * 2 + 1] = allm; }
    __syncthreads();
    float cG = 0.f, cM = m0;
    for (int s2 = 0; s2 < sg; ++s2) { cM = fmaxf(cM, sx[(dir * 4 + s2) * 2 + 1] - cG); cG += sx[(dir * 4 + s2) * 2]; }
    float cm = mx;
#pragma unroll
    for (int o = 1; o < 64 / EL; o <<= 1) cm = fmaxf(cm, __shfl_xor(cm, o));
    cm -= cG;
    const int p0 = sg * SL + lane * EL, t0 = dir ? T - 1 - p0 : p0, ch = t0 >> 6;
    if ((lane & (64 / EL - 1)) == 0) Rc[ch] = cm;
#pragma unroll
    for (int e = 0; e < EL; ++e) { const int p = p0 + e, t = dir ? T - 1 - p : p;
        const float a = gi[e] - cG, Gv = gf[e] + cG, Mv = fmaxf(fmaxf(cM, ex - cG), pmx[e] - cG);
        Et[t] = ex2((a - cm) * LOG2E);
        if (ch == qb) { Ad[t & 63] = a; MG[(t & 63) * 2] = Mv; MG[(t & 63) * 2 + 1] = Gv; } }
}

DI void phaseB(const Args& A, ldsp lds, int G, int bid, int tid) {
    const int lane = tid & 63, wave = __builtin_amdgcn_readfirstlane(tid >> 6), r32 = lane & 31, h2 = lane >> 5, i16 = lane & 15, tq = i16 >> 2, tp = i16 & 3, blk = (lane >> 4) & 1;
    const int qsub = wave & 1, dvh = (wave >> 1) & 1, dir = wave >> 2;
    const bf16* QKV = (const bf16*)(A.ws + WS_QKV); bf16* O = (bf16*)(A.ws + WS_O); const float* gates = (const float*)(A.ws + WS_GATES);
    LAS float* At = (LAS float*)(lds + BL_ET); LAS float* Mt = At + 256; LAS float* Gt = Mt + 256;
    LAS float* sx = (LAS float*)(lds + BL_SX);
    LAS float* xb = (LAS float*)lds;
    const float scale = 0.08838834764831845f;
    const int kx = r32 & 15, krow = r32 * 256;
    const int vbase = (4 * h2 + tq) * 512 + 32 * blk + 8 * tp;
    for (int u = bid; u < 1024; u += G) {
        int latent, b, h, qb, T, rowbase;
        if (u < 512) { const int uu = (G == 256) ? ((((u >> 8) * 64 + (bid & 7) * 8 + (bid >> 5)) << 2) | ((bid >> 3) & 3)) : u;
            latent = 0; b = uu >> 5; h = (uu >> 2) & 7; qb = uu & 3; T = 256; rowbase = b * 256; }
        else { const int v0 = u - 512; const int v = (G == 256) ? ((((v0 >> 8) * 16 + (bid & 7) * 2 + (bid >> 7)) << 4) | ((bid >> 3) & 15)) : v0;
            latent = 1; b = v >> 7; h = (v >> 4) & 7; qb = v & 15; T = 1024; rowbase = NCTX + b * 1024; }
        const int nch = T / 64;
        { const float m0s = latent ? A.in[6][(b * 2 + dir) * 8 + h] : 0.f;
          if (latent) mlstm_scan8<4>(gates, rowbase, h, T, qb, m0s, lds, wave, lane); else mlstm_scan8<1>(gates, rowbase, h, T, qb, m0s, lds, wave, lane); }
        __syncthreads();
        const int t = 64 * qb + 32 * qsub + r32, row = rowbase + t;
        const float Mq = ((LAS float*)(lds + BL_MG))[dir * 128 + (32 * qsub + r32) * 2], Gq = ((LAS float*)(lds + BL_MG))[dir * 128 + (32 * qsub + r32) * 2 + 1];
        const LAS float* Et = (const LAS float*)(lds + BL_ET) + dir * 1024; const LAS float* Rc = (const LAS float*)(lds + BL_RC) + dir * 16; const LAS float* Ad = (const LAS float*)(lds + BL_AD) + dir * 64;
        bf16x8 qr[8];
#pragma unroll
        for (int d0 = 0; d0 < 8; ++d0) qr[d0] = *(const bf16x8*)(QKV + (size_t)row * 6144 + h * 128 + 16 * d0 + 8 * h2);
        f32x16 o[4];
#pragma unroll
        for (int d0 = 0; d0 < 4; ++d0)
#pragma unroll
            for (int r = 0; r < 16; ++r) o[d0][r] = 0.f;
        float den = 0.f;
        const bf16* kp0 = QKV + (size_t)rowbase * 6144 + 1024 + h * 128; const bf16* vp0 = QKV + (size_t)rowbase * 6144 + 2048 + h * 256;
        asm volatile("s_waitcnt vmcnt(0) lgkmcnt(0)" ::: "memory");
#pragma unroll
        for (int d0 = 0; d0 < 8; ++d0) asm volatile("" : "+v"(qr[d0]));
#ifdef DUP_BLOOP
        for (int rep = 0; rep < 2; ++rep) {
#pragma unroll
        for (int d0 = 0; d0 < 4; ++d0)
#pragma unroll
            for (int r = 0; r < 16; ++r) o[d0][r] = 0.f;
        den = 0.f;
#endif
#pragma unroll
        for (int k = 0; k < 2; ++k) { ldsp sb = lds + k * BR_STG; dma_tile<256, false>(sb, kp0 + (size_t)(64 * k) * 6144, 6144, wave, lane); dma_tile<512, true>(sb + BR_K, vp0 + (size_t)(64 * k) * 6144, 6144, wave, lane); }
        for (int c = 0; c < nch; ++c) {
            if (c + 1 < nch) VM_WAIT_N(6); else VM_WAIT_N(0);
            __builtin_amdgcn_s_barrier(); asm volatile("" ::: "memory");
            if (c + 2 < nch) { const int stg = (c + 2) % BR_NS; ldsp sb = lds + stg * BR_STG; dma_tile<256, false>(sb, kp0 + (size_t)(64 * (c + 2)) * 6144, 6144, wave, lane); dma_tile<512, true>(sb + BR_K, vp0 + (size_t)(64 * (c + 2)) * 6144, 6144, wave, lane); }
            ldsp kb = lds + (c % BR_NS) * BR_STG; ldsp vb = kb + BR_K;
            const bool act = dir ? (c >= qb) : (c <= qb);
            if (act) {
                const bool diag = (c == qb);
                const float fc = ex2((Rc[c] - Mq) * LOG2E) * scale;
#pragma unroll
                for (int kt = 0; kt < 2; ++kt) {
                    const bool tact = !(diag && (dir ? kt < qsub : kt > qsub));
                    if (tact) {
                        f32x16 s;
#pragma unroll
                        for (int i = 0; i < 16; ++i) s[i] = 0.f;
#pragma unroll
                        for (int d0 = 0; d0 < 8; ++d0) { const bf16x8 a = *(const LAS bf16x8*)(kb + 32 * kt * 256 + krow + (((h2 + 2 * d0) ^ kx) << 4)); s = MFMA32(a, qr[d0], s); }
                        int h2l = h2; asm volatile("" : "+v"(h2l));
                        if (!diag) {
#pragma unroll
                            for (int g = 0; g < 4; ++g) { const f32x4 e4 = *(const LAS f32x4*)(Et + 64 * c + 32 * kt + 8 * g + 4 * h2l);
#pragma unroll
                                for (int j = 0; j < 4; ++j) { const float p = s[4 * g + j] * (e4[j] * fc); s[4 * g + j] = p; den += p; } }
                        } else {
#pragma unroll
                            for (int g = 0; g < 4; ++g) { const f32x4 a4 = *(const LAS f32x4*)(Ad + 32 * kt + 8 * g + 4 * h2l);
#pragma unroll
                                for (int j = 0; j < 4; ++j) { const int si = 64 * c + 32 * kt + 8 * g + 4 * h2l + j; const float w = ex2((a4[j] - Mq) * LOG2E);
                                    const bool ok = dir ? si >= t : si <= t; const float p = ok ? s[4 * g + j] * scale * w : 0.f; s[4 * g + j] = p; den += p; } }
                        }
                        const bf16x8 p0 = pack8<0>(s), p1 = pack8<1>(s);
                        const unsigned va0 = (unsigned)(__UINTPTR_TYPE__)vb + (unsigned)((32 * kt) * 512 + vbase);
#pragma unroll
                        for (int dp = 0; dp < 2; ++dp) {
                            const unsigned a = va0 + 64 * ((4 * dvh + 2 * dp) ^ tq), bq = va0 + 64 * ((4 * dvh + 2 * dp + 1) ^ tq);
                            const s16x4 l0 = tr_asm<0>(a), h0 = tr_asm<8 * 512>(a), l1 = tr_asm<16 * 512>(a), h1 = tr_asm<24 * 512>(a);
                            const s16x4 m0 = tr_asm<0>(bq), n0 = tr_asm<8 * 512>(bq), m1 = tr_asm<16 * 512>(bq), n1 = tr_asm<24 * 512>(bq);
                            asm volatile("s_waitcnt lgkmcnt(0)" ::: "memory"); __builtin_amdgcn_sched_barrier(0);
                            const bf16x8 a0 = {l0[0], l0[1], l0[2], l0[3], h0[0], h0[1], h0[2], h0[3]};
                            const bf16x8 a1 = {l1[0], l1[1], l1[2], l1[3], h1[0], h1[1], h1[2], h1[3]};
                            const bf16x8 b0 = {m0[0], m0[1], m0[2], m0[3], n0[0], n0[1], n0[2], n0[3]};
                            const bf16x8 b1 = {m1[0], m1[1], m1[2], m1[3], n1[0], n1[1], n1[2], n1[3]};
                            o[2 * dp] = MFMA32(a0, p0, o[2 * dp]);
                            o[2 * dp + 1] = MFMA32(b0, p0, o[2 * dp + 1]);
                            o[2 * dp] = MFMA32(a1, p1, o[2 * dp]);
                            o[2 * dp + 1] = MFMA32(b1, p1, o[2 * dp + 1]);
                        }
                    }
                }
            }
        }
        asm volatile("s_waitcnt lgkmcnt(0)" ::: "memory"); __builtin_amdgcn_s_barrier(); asm volatile("" ::: "memory");
#ifdef DUP_BLOOP
        }
#endif
        den = hsum(den);
#ifndef NO_BSTATE
        if (latent) {
            const float m0 = A.in[6][(b * 2 + dir) * 8 + h];
            const float coef = ex2((m0 - Mq) * LOG2E) * scale;
            const bf16* SC = (const bf16*)(A.ws + WS_SC) + ((size_t)((b * 2 + dir) * 8 + h) * 256 + dvh * 128 + r32) * 128 + 8 * h2;
#pragma unroll
            for (int d0 = 0; d0 < 4; ++d0) { f32x16 tmp;
#pragma unroll
                for (int r = 0; r < 16; ++r) tmp[r] = 0.f;
#pragma unroll
                for (int ds = 0; ds < 8; ++ds) { const bf16x8 a = *(const bf16x8*)(SC + (size_t)d0 * 32 * 128 + 16 * ds); tmp = MFMA32(a, qr[ds], tmp); }
#pragma unroll
                for (int r = 0; r < 16; ++r) o[d0][r] += coef * tmp[r]; }
            const float* n0 = A.in[5] + ((b * 2 + dir) * 8 + h) * 128 + 8 * h2;
            float dot = 0.f;
#pragma unroll
            for (int ds = 0; ds < 8; ++ds)
#pragma unroll
                for (int jj = 0; jj < 8; ++jj) dot += bf2f((unsigned short)qr[ds][jj]) * n0[16 * ds + jj];
            dot = hsum(dot);
            den += coef * dot;
        }
#endif
        const float hinv = 1.0f / fmaxf(fabsf(den), __expf(-(Gq + Mq)));
        if (dir == 1) {
#pragma unroll
            for (int d0 = 0; d0 < 4; ++d0)
#pragma unroll
                for (int r = 0; r < 16; ++r) xb[(((wave & 3) * 4 + d0) * 16 + r) * 64 + lane] = o[d0][r] * hinv;
        }
        __syncthreads();
        float ss = 0.f;
        if (dir == 0) {
#pragma unroll
            for (int d0 = 0; d0 < 4; ++d0)
#pragma unroll
                for (int r = 0; r < 16; ++r) { const float v = o[d0][r] * hinv + xb[((wave * 4 + d0) * 16 + r) * 64 + lane]; o[d0][r] = v; ss += v * v; }
            ss = hsum(ss);
            if (h2 == 0) sx[wave * 32 + r32] = ss;
        }
        __syncthreads();
        if (dir == 0) {
            const float tot = ss + sx[(wave ^ 2) * 32 + r32];
            const float rs = 1.0f / sqrtf(tot * (1.f / 256.f) + RMS_EPS);
            const float* nw = A.in[25] + h * 256 + dvh * 128; const bf16* og = QKV + (size_t)row * 6144 + 4096 + h * 256 + dvh * 128;
#pragma unroll
            for (int d0 = 0; d0 < 4; ++d0)
#pragma unroll
                for (int g = 0; g < 4; ++g) { const int dv = 32 * d0 + 8 * g + 4 * h2;
                    const u32x2 ow = *(const u32x2*)(og + dv); const f32x4 nv = *(const f32x4*)(nw + dv);
                    const float g0 = 1.f / (1.f + __expf(-bflo(ow.x))), g1 = 1.f / (1.f + __expf(-bfhi(ow.x))), g2 = 1.f / (1.f + __expf(-bflo(ow.y))), g3 = 1.f / (1.f + __expf(-bfhi(ow.y)));
                    u32x2 w; w.x = pk2(o[d0][4 * g] * rs * nv[0] * g0, o[d0][4 * g + 1] * rs * nv[1] * g1); w.y = pk2(o[d0][4 * g + 2] * rs * nv[2] * g2, o[d0][4 * g + 3] * rs * nv[3] * g3);
                    *(u32x2*)(O + (size_t)row * DM + h * 256 + dvh * 128 + dv) = w; }
        }
        __syncthreads();
    }
    LAS float* Wt = sx + 256;
#ifndef NO_BFINAL
    for (int u = bid; u < 256; u += G) {
        const int b = u >> 4, h = (u >> 1) & 7, sd = u & 1, rowbase = b * 256;
        if (wave == 0) mlstm_scan(gates, rowbase, h, sd, 0.f, 256, At, Mt, Gt, lane);
        __syncthreads();
        const int tl = sd ? 0 : 255;
        const float MT = Mt[tl], GT = Gt[tl];
        if (tid < 256) Wt[tid] = ex2((At[tid] - MT) * LOG2E);
        __syncthreads();
        f32x16 acc[4];
#pragma unroll
        for (int nt = 0; nt < 4; ++nt)
#pragma unroll
            for (int r = 0; r < 16; ++r) acc[nt][r] = 0.f;
        float nacc = 0.f;
        const int aoff = (8 * h2 + tq) * B_PVB + (32 * wave + 16 * blk + 4 * tp) * 2;
        const int boff = (8 * h2 + tq) * B_PKB + (16 * blk + 4 * tp) * 2;
        bf16x8 kst[2], vst[4];
        { const bf16* kp = QKV + (size_t)rowbase * 6144 + 1024 + h * 128; const bf16* vp = QKV + (size_t)rowbase * 6144 + 2048 + h * 256;
          stage_ld<128>(kst, kp, 6144, tid); stage_ld<256>(vst, vp, 6144, tid); }
        for (int c = 0; c < 4; ++c) {
            ldsp kb = lds + (c & 1) * B_BUF; ldsp vb = kb + B_KBYTES;
#pragma unroll
            for (int i = 0; i < 4; ++i) { const int idx = tid + NTHR * i, rw = idx / 32; const float w = Wt[64 * c + rw];
                const u32x4 x = __builtin_bit_cast(u32x4, vst[i]); u32x4 y;
                y.x = pk2(bflo(x.x) * w, bfhi(x.x) * w); y.y = pk2(bflo(x.y) * w, bfhi(x.y) * w); y.z = pk2(bflo(x.z) * w, bfhi(x.z) * w); y.w = pk2(bflo(x.w) * w, bfhi(x.w) * w);
                vst[i] = __builtin_bit_cast(bf16x8, y); }
            stage_st<128>(kst, kb, B_PKB, tid); stage_st<256>(vst, vb, B_PVB, tid);
            __syncthreads();
            if (c + 1 < 4) { const bf16* kp = QKV + (size_t)(rowbase + 64 * (c + 1)) * 6144 + 1024 + h * 128; const bf16* vp = QKV + (size_t)(rowbase + 64 * (c + 1)) * 6144 + 2048 + h * 256;
                stage_ld<128>(kst, kp, 6144, tid); stage_ld<256>(vst, vp, 6144, tid); }
#pragma unroll
            for (int ks = 0; ks < 4; ++ks) {
                const s16x4 al = tr_read(vb + aoff + 16 * ks * B_PVB), ah = tr_read(vb + aoff + (16 * ks + 4) * B_PVB);
                const bf16x8 a = {al[0], al[1], al[2], al[3], ah[0], ah[1], ah[2], ah[3]};
#pragma unroll
                for (int nt = 0; nt < 4; ++nt) {
                    const s16x4 bl = tr_read(kb + boff + 16 * ks * B_PKB + 64 * nt), bh = tr_read(kb + boff + (16 * ks + 4) * B_PKB + 64 * nt);
                    const bf16x8 bb = {bl[0], bl[1], bl[2], bl[3], bh[0], bh[1], bh[2], bh[3]};
                    acc[nt] = MFMA32(a, bb, acc[nt]);
                }
            }
            if (tid < 128) {
#pragma unroll 8
                for (int s = 0; s < 64; ++s) nacc += Wt[64 * c + s] * bf2f(*(const LAS unsigned short*)(kb + s * B_PKB + tid * 2));
            }
        }
        float* oc = A.out + O_BC + ((size_t)((b * 2 + sd) * 8 + h) * 256) * 128;
#pragma unroll
        for (int nt = 0; nt < 4; ++nt)
#pragma unroll
            for (int r = 0; r < 16; ++r) oc[(size_t)(32 * wave + crow(r, h2)) * 128 + 32 * nt + r32] = acc[nt][r];
        if (tid < 128) A.out[O_BN + ((b * 2 + sd) * 8 + h) * 128 + tid] = nacc;
        if (tid == 0) A.out[O_BM + (b * 2 + sd) * 8 + h] = GT + MT;
        __syncthreads();
    }
#endif
}

constexpr int N_PHASES = 3 + 7 * NLAYER;
#define PH(b) ((MASK >> (b)) & 1)
#ifndef DUPMASK
#define DUPMASK 0
#endif
#define DUP(b) (((DUPMASK >> (b)) & 1) ? 2 : 1)
template <int MASK> __global__ void __launch_bounds__(NTHR, 2) fwd_kernel(Args args) {
    extern __shared__ __attribute__((aligned(16))) unsigned char lds_raw[];
    ldsp lds = (ldsp)lds_raw;
    const int tid0 = threadIdx.x, bid = blockIdx.x, G = gridDim.x;
#define TIDL() ({ int t_ = threadIdx.x; asm volatile("" : "+v"(t_)); t_; })
    const int tid = tid0;
    volatile LAS unsigned* MISC = (volatile LAS unsigned*)(lds + MISC_OFF);
    for (int u = tid; u < 64; u += NTHR) MISC[u] = 0u;
    __syncthreads();
    const int lo = args.ph_lo, hi = args.ph_hi;
    unsigned* ctl = (unsigned*)(args.ws + WS_CTL);
    XcdBarrier bar; bar.bar = ctl + CW_BAR; bar.x = 0; bar.st = nullptr;
    const bool multi = (hi - lo) > 1;
    if (multi) bar = xcd_barrier_post(ctl + CW_BAR, MISC + 8);
#define IN(k) (lo <= (k) && (k) < hi)
#define SEAM(k) do { if (IN(k) && IN((k) + 1)) xcd_barrier(bar); } while (0)
    unsigned char* ws = args.ws;
    bf16* Hb = (bf16*)(ws + WS_H); bf16* QKVb = (bf16*)(ws + WS_QKV); bf16* Ob = (bf16*)(ws + WS_O); bf16* Yb = (bf16*)(ws + WS_Y); bf16* Ub = (bf16*)(ws + WS_U);

    if (DUP(12) == 2 && multi) { for (int rep = 0; rep < 32; ++rep) xcd_barrier(bar); }
    if (PH(0) && IN(0)) { for (int rep = 0; rep < DUP(0); ++rep) { p0a_prologue(args, lds, G, bid, TIDL()); __syncthreads(); } } SEAM(0);
    if (PH(1) && IN(1)) { p0b_modreduce(args, G, bid, TIDL()); } SEAM(1);
    if (PH(2) && IN(2)) { RowP P; P.Y = nullptr; P.mod_gate = 0; P.Lg = 0; P.gpost = 0; P.has_next = 1; P.Ln = 0; P.gpre = 0; P.mod_shift = 0; P.do_gates = 0; P.dry = 0; row_phase(args, P, lds, G, bid, TIDL()); } SEAM(2);

    for (int L = 0; L < NLAYER; ++L) {
        const int base = 3 + 7 * L;
        if (PH(3) && IN(base)) {
            pg8::EpiInProj E; E.O = QKVb; E.rtab = (const float*)(ws + WS_ROPE);
            const bf16* Wt; int N;
            if (L == 0)      { Wt = (const bf16*)(ws + W_AIN); N = 6144; E.ck = args.out + O_AK; E.cv = args.out + O_AV; E.kc0 = 2048; E.vc0 = 4096; E.kw = 2048; E.rope_cols = 4096; }
            else if (L == 1) { Wt = (const bf16*)(ws + W_BIN); N = 6144; E.ck = nullptr; E.cv = nullptr; E.kc0 = 0; E.vc0 = 0; E.kw = 0; E.rope_cols = 0; }
            else if (L == 2) { Wt = (const bf16*)(ws + W_CIN); N = 6144; E.ck = args.out + O_CK; E.cv = args.out + O_CV; E.kc0 = 2048; E.vc0 = 4096; E.kw = 2048; E.rope_cols = 0; }
            else             { Wt = (const bf16*)(ws + W_DIN); N = 3072; E.ck = args.out + O_DK; E.cv = args.out + O_DV; E.kc0 = 2048; E.vc0 = 2560; E.kw = 512; E.rope_cols = 2560; }
            E.ldc = N;
            pg8::Gemm g{Hb, Wt, NTOK, N, DM}; pg8::StaticOrder S; S.init(NTOK, N, G, bid);
            for (int rep = 0; rep < DUP(3); ++rep) { pg8::gemm_phase<pg8::EpiInProj, pg8::StaticOrder, false, true>((LAS unsigned char*)lds, g, S, E); __syncthreads(); }
        }
        SEAM(base);
        if (IN(base + 1)) { for (int rep = 0; rep < DUP(4 + L); ++rep) {
            if (PH(4) && L == 0) phaseA(args, lds, G, bid, TIDL());
            if (PH(5) && L == 1) phaseB(args, lds, G, bid, TIDL());
            if (PH(6) && L == 2) phaseC(args, lds, G, bid, TIDL());
            if (PH(7) && L == 3) phaseD(args, lds, G, bid, TIDL());
        } }
        SEAM(base + 1);
        if (PH(8) && IN(base + 2)) {
            const size_t wo = L == 0 ? W_AOUT : (L == 1 ? W_BOUT : (L == 2 ? W_COUT : W_DOUT));
            pg8::Gemm g{Ob, (const bf16*)(ws + wo), NTOK, DM, DM}; pg8::StaticOrder S; S.init(NTOK, DM, G, bid);
            pg8::EpiBf16<false> E{Yb, DM};
            for (int rep = 0; rep < DUP(8); ++rep) { pg8::gemm_phase<pg8::EpiBf16<false>, pg8::StaticOrder, true, true>((LAS unsigned char*)lds, g, S, E); __syncthreads(); }
        }
        SEAM(base + 2);
        if (PH(2) && IN(base + 3)) { RowP P; P.Y = Yb; P.mod_gate = 2; P.Lg = L; P.gpost = L * 4 + 1; P.has_next = 1; P.Ln = L; P.gpre = L * 4 + 2; P.mod_shift = 3; P.do_gates = 0; P.dry = 1; if (DUP(2) == 2) { row_phase(args, P, lds, G, bid, TIDL()); __syncthreads(); } P.dry = 0; row_phase(args, P, lds, G, bid, TIDL()); }
        SEAM(base + 3);
        if (PH(9) && IN(base + 4)) {
            pg8::Gemm g{Hb, (const bf16*)(ws + W_FF1) + (size_t)L * DM * DFF, NTOK, DFF, DM}; pg8::StaticOrder S; S.init(NTOK, DFF, G, bid);
            pg8::EpiBf16<true> E{Ub, DFF};
            for (int rep = 0; rep < DUP(9); ++rep) { pg8::gemm_phase<pg8::EpiBf16<true>, pg8::StaticOrder, false, true>((LAS unsigned char*)lds, g, S, E); __syncthreads(); }
        }
        SEAM(base + 4);
        if (PH(10) && IN(base + 5)) {
            pg8::Gemm g{Ub, (const bf16*)(ws + W_FF2) + (size_t)L * DM * DFF, NTOK, DM, DFF}; pg8::StaticOrder S; S.init(NTOK, DM, G, bid);
            pg8::EpiBf16<false> E{Yb, DM};
            for (int rep = 0; rep < DUP(10); ++rep) { pg8::gemm_phase<pg8::EpiBf16<false>, pg8::StaticOrder, true, true>((LAS unsigned char*)lds, g, S, E); __syncthreads(); }
        }
        SEAM(base + 5);
        if (PH(2) && IN(base + 6)) { RowP P; P.Y = Yb; P.mod_gate = 5; P.Lg = L; P.gpost = L * 4 + 3; P.has_next = (L + 1 < NLAYER); P.Ln = L + 1; P.gpre = (L + 1) * 4; P.mod_shift = 0; P.do_gates = (L + 1 == 1); P.dry = 1; if (DUP(2) == 2) { row_phase(args, P, lds, G, bid, TIDL()); __syncthreads(); } P.dry = 0; row_phase(args, P, lds, G, bid, TIDL()); }
        SEAM(base + 6);
    }
#undef IN
#undef SEAM
}

#ifndef FULLMASK
#define FULLMASK 0xFFFF
#endif
#ifndef MK_PER_PHASE
#define MK_PER_PHASE 0
#endif
template <int MASK> static int setup_kernel() {
    if (hipFuncSetAttribute((const void*)fwd_kernel<MASK>, hipFuncAttributeMaxDynamicSharedMemorySize, LDS_BYTES) != hipSuccess) { fprintf(stderr, "kernel_launch: hipFuncSetAttribute failed (mask %x)\n", MASK); return -1; }
    return 0;
}
template <int MASK> static void launch_range(const Args& a, int grid, hipStream_t stream) { hipLaunchKernelGGL(fwd_kernel<MASK>, dim3(grid), dim3(NTHR), LDS_BYTES, stream, a); }
extern "C" void kernel_launch(void* const* d_in, const int* in_sizes, int n_in, void* d_out, int out_size, void* d_ws, size_t ws_size, hipStream_t stream) {
    static int grid = 0;
    if (grid == 0) {
        if (n_in != 32 || out_size != (int)O_END || ws_size < WS_END) { fprintf(stderr, "kernel_launch: unexpected shapes: n_in %d out %d ws %zu (need %zu)\n", n_in, out_size, ws_size, (size_t)WS_END); grid = -1; return; }
        int dev = 0, cus = 0;
        if (hipGetDevice(&dev) != hipSuccess || hipDeviceGetAttribute(&cus, hipDeviceAttributeMultiprocessorCount, dev) != hipSuccess) { grid = -1; return; }
#if MK_PER_PHASE
        if (setup_kernel<1>() || setup_kernel<2>() || setup_kernel<4>() || setup_kernel<8>() || setup_kernel<16>() || setup_kernel<32>() || setup_kernel<64>() || setup_kernel<128>() || setup_kernel<256>() || setup_kernel<512>() || setup_kernel<1024>()) { grid = -1; return; }
#else
        if (setup_kernel<FULLMASK>()) { grid = -1; return; }
#endif
        (void)hipGetLastError();
        grid = cus;
    }
    if (grid < 0) return;
    (void)hipMemsetAsync((char*)d_ws + WS_CTL, 0, CTL_ZERO_BYTES, stream);
    Args a{};
    for (int i = 0; i < 32; ++i) a.in[i] = (const float*)d_in[i];
    a.out = (float*)d_out; a.ws = (unsigned char*)d_ws;
#if MK_PER_PHASE
    for (int p = 0; p < N_PHASES; ++p) {
        a.ph_lo = p; a.ph_hi = p + 1;
        if (p == 0) launch_range<1>(a, grid, stream);
        else if (p == 1) launch_range<2>(a, grid, stream);
        else if (p == 2) launch_range<4>(a, grid, stream);
        else { const int L = (p - 3) / 7, k = (p - 3) % 7;
            if (k == 0) launch_range<8>(a, grid, stream);
            else if (k == 1) { if (L == 0) launch_range<16>(a, grid, stream); else if (L == 1) launch_range<32>(a, grid, stream); else if (L == 2) launch_range<64>(a, grid, stream); else launch_range<128>(a, grid, stream); }
            else if (k == 2) launch_range<256>(a, grid, stream);
            else if (k == 3 || k == 6) launch_range<4>(a, grid, stream);
            else if (k == 4) launch_range<512>(a, grid, stream);
            else launch_range<1024>(a, grid, stream);
        }
    }
#else
    a.ph_lo = 0; a.ph_hi = N_PHASES; launch_range<FULLMASK>(a, grid, stream);
#endif
    const hipError_t le = hipPeekAtLastError();
    if (le != hipSuccess) fprintf(stderr, "kernel_launch: launch failed: %s\n", hipGetErrorName(le));
}
```

```cpp
#include <hip/hip_runtime.h>
#include <cstdio>
#include <cstdint>
#include <cmath>
namespace pg8 {
#define PG8_LAS __attribute__((address_space(3)))
typedef unsigned short bf16_t;
typedef short bf16x8 __attribute__((ext_vector_type(8)));
typedef float f32x4 __attribute__((ext_vector_type(4)));
typedef unsigned u32x4 __attribute__((ext_vector_type(4)));
constexpr int BM = 256, BK = 64, HALF = 128, HTB = HALF * BK * 2  , STAGE_BYTES = 8 * HTB, NXCD = 8, WGM = 8;

__host__ __device__ __forceinline__ int lds_byte(int r, int c) { const int st = (r >> 4) * 2 + (c >> 5), rr = r & 15, cc = c & 31, ob = rr * 64 + cc * 2; return st * 1024 + (ob ^ (((ob >> 9) & 1) << 5)); }
__host__ __device__ __forceinline__ void stage_rc(int b, int& R, int& C) { const int st = b / 1024, sb = b % 1024, swz = sb ^ (((sb >> 9) & 1) << 5); R = (st >> 1) * 16 + swz / 64; C = (st & 1) * 32 + (swz % 64) / 2; }
__host__ __device__ __forceinline__ int perm32(int rho) { const int n = rho >> 4, i = rho & 15; return 8 * (i >> 2) + 4 * n + (i & 3); }

struct Unit { int pm, pn; };
struct Gemm { const bf16_t* A; const bf16_t* Bt; int M, N, K; };

struct StaticOrder {
    int nM, nN, nwg, G, c;
    __host__ __device__ void init(int M, int N, int G_, int c_) { nM = M / BM; nN = N / BM; nwg = nM * nN; G = G_; c = c_; }
    __host__ __device__ bool next(int i, Unit& u) const {
        const long L = (long)i * G + c; if (L >= nwg) return false;
        int wgid = (int)L; { const int q = nwg / NXCD, r = nwg % NXCD, xcd = wgid % NXCD, off = wgid / NXCD; wgid = (xcd < r ? xcd * (q + 1) : r * (q + 1) + (xcd - r) * q) + off; }
        const int nig = WGM * nN, gid = wgid / nig, fm = gid * WGM, gsz = (nM - fm) < WGM ? (nM - fm) : WGM;
        u.pm = fm + ((wgid % nig) % gsz); u.pn = (wgid % nig) / gsz; return true;
    }
    __device__ __forceinline__ void a_ready(const Unit&) const {}
    __device__ __forceinline__ void done(const Unit&) const {}
};

__device__ __forceinline__ unsigned cvt_pk_bf16(float lo, float hi) { unsigned r; asm volatile("v_cvt_pk_bf16_f32 %0, %1, %2" : "=v"(r) : "v"(lo), "v"(hi)); return r; }
typedef float f32x2 __attribute__((ext_vector_type(2)));

struct EpiF32 {
    static constexpr bool PERM = false, AFTER_DRAIN = false;
    float* C; int ldc;
    __device__ __forceinline__ void operator()(const f32x4 (&acc)[2][2][4][2], const Unit& u, int wr, int wc, int fr, int fq) const {
        const int row0 = u.pm * BM + wr * 64 + fr, col0 = u.pn * BM + wc * 32 + 4 * fq;
#pragma unroll
        for (int ai = 0; ai < 2; ++ai)
#pragma unroll
            for (int m = 0; m < 4; ++m) { float* rowp = C + (size_t)(row0 + ai * HALF + m * 16) * ldc + col0;
#pragma unroll
                for (int bj = 0; bj < 2; ++bj)
#pragma unroll
                    for (int n = 0; n < 2; ++n) *(f32x4*)(rowp + bj * HALF + n * 16) = acc[ai][bj][m][n]; }
    }
};
template <bool ACT> struct EpiBf16 {
    static constexpr bool PERM = true, AFTER_DRAIN = false;
    bf16_t* O; int ldc;
    __device__ __forceinline__ void operator()(const f32x4 (&acc)[2][2][4][2], const Unit& u, int wr, int wc, int fr, int fq) const {
        const int row0 = u.pm * BM + wr * 64 + fr, col0 = u.pn * BM + wc * 32 + 8 * fq;
#pragma unroll
        for (int ai = 0; ai < 2; ++ai)
#pragma unroll
            for (int m = 0; m < 4; ++m) { bf16_t* rowp = O + (size_t)(row0 + ai * HALF + m * 16) * ldc + col0;
#pragma unroll
                for (int bj = 0; bj < 2; ++bj) { f32x4 v0 = acc[ai][bj][m][0], v1 = acc[ai][bj][m][1];
#pragma unroll
                    for (int e = 0; e < 4; ++e) { if (ACT) { const float a = fmaxf(v0[e], 0.f), b = fmaxf(v1[e], 0.f); v0[e] = a * a; v1[e] = b * b; } }
                    u32x4 w; w.x = cvt_pk_bf16(v0[0], v0[1]); w.y = cvt_pk_bf16(v0[2], v0[3]); w.z = cvt_pk_bf16(v1[0], v1[1]); w.w = cvt_pk_bf16(v1[2], v1[3]);
                    *(u32x4*)(rowp + bj * HALF) = w; } }
    }
};
struct EpiInProj {
    static constexpr bool PERM = true, AFTER_DRAIN = false;
    bf16_t* O; int ldc;
    float* ck; float* cv;
    int kc0, vc0, kw;
    int rope_cols;
    const float* rtab;
    __device__ __forceinline__ void operator()(const f32x4 (&acc)[2][2][4][2], const Unit& u, int wr, int wc, int fr, int fq) const {
        const int row0 = u.pm * BM + wr * 64 + fr, colt = u.pn * BM, col0 = colt + wc * 32 + 8 * fq;
        float* cdst = nullptr; int ccol = 0;
        if (u.pm < 16 && ck != nullptr) {
            if (colt >= kc0 && colt < kc0 + kw) { cdst = ck; ccol = col0 - kc0; }
            else if (colt >= vc0 && colt < vc0 + kw) { cdst = cv; ccol = col0 - vc0; }
        }
        const bool rope = (u.pm >= 16) && (colt < rope_cols);
#pragma unroll
        for (int ai = 0; ai < 2; ++ai)
#pragma unroll
            for (int m = 0; m < 4; ++m) {
                const int row = row0 + ai * HALF + m * 16;
                bf16_t* rowp = O + (size_t)row * ldc + col0;
                int pos = 0; if (rope) { const int t = row & 1023; pos = (wc & 1) ? (t & 63) : (t >> 6); }
                const f32x4* tb = (const f32x4*)(rtab + (pos * 16 + 8 * (fq & 1)) * 2);
#pragma unroll
                for (int bj = 0; bj < 2; ++bj) { f32x4 v0 = acc[ai][bj][m][0], v1 = acc[ai][bj][m][1];
                    if (rope) {
                        const f32x4 t0 = tb[0], t1 = tb[1], t2 = tb[2], t3 = tb[3];
                        const float cs[8] = {t0[0], t0[2], t1[0], t1[2], t2[0], t2[2], t3[0], t3[2]};
                        const float sn[8] = {t0[1], t0[3], t1[1], t1[3], t2[1], t2[3], t3[1], t3[3]};
#pragma unroll
                        for (int e = 0; e < 4; ++e) {
                            const float a = v0[e], pa = __shfl_xor(a, 32), b = v1[e], pb = __shfl_xor(b, 32);
                            v0[e] = (fq < 2) ? a * cs[e] - pa * sn[e] : pa * sn[e] + a * cs[e];
                            v1[e] = (fq < 2) ? b * cs[4 + e] - pb * sn[4 + e] : pb * sn[4 + e] + b * cs[4 + e];
                        }
                    }
                    u32x4 w; w.x = cvt_pk_bf16(v0[0], v0[1]); w.y = cvt_pk_bf16(v0[2], v0[3]); w.z = cvt_pk_bf16(v1[0], v1[1]); w.w = cvt_pk_bf16(v1[2], v1[3]);
                    *(u32x4*)(rowp + bj * HALF) = w;
                    if (cdst) { float* cp = cdst + (size_t)row * kw + ccol + bj * HALF; *(f32x4*)cp = v0; *(f32x4*)(cp + 4) = v1; }
                } }
    }
};

template <class Epi, class Sched, bool ALIGN_EPI = false, bool SP2 = false>
__device__ __forceinline__ void gemm_phase(PG8_LAS unsigned char* lds, const Gemm g, const Sched& S, const Epi& E) {
    int tid_raw = threadIdx.x; asm volatile("" : "+v"(tid_raw));
    const int tid = tid_raw, wid = __builtin_amdgcn_readfirstlane(tid >> 6), lane = tid & 63, wr = wid >> 2, wc = wid & 3, fr = lane & 15, fq = lane >> 4;
    const int K = g.K, nt = K / BK;
    unsigned voffA[2], voffB[2];
#pragma unroll
    for (int i = 0; i < 2; ++i) { int R, C; stage_rc(tid * 16 + i * 8192, R, C); const int Rb = Epi::PERM ? ((R & ~31) + perm32(R & 31)) : R;
        voffA[i] = (unsigned)(R * K + C) * 2u; voffB[i] = (unsigned)(Rb * K + C) * 2u; }
    const size_t kstep = (size_t)(BK * 2);
    const size_t hstep = (size_t)HALF * K * 2;
    const size_t tstep = 2 * hstep;
    const unsigned ldsw = (unsigned)wid * 1024u;
    const int aoff = lds_byte(wr * 64 + fr, fq * 8), boff = lds_byte(wc * 32 + fr, fq * 8);
#define PG8_SA(b, h) (((b) * 2 + (h)) * HTB)
#define PG8_SB(b, h) ((4 + (b) * 2 + (h)) * HTB)
#define PG8_STAGE(bufoff, gbase, voff) do { _Pragma("unroll") for (int _i = 0; _i < 2; ++_i) \
        __builtin_amdgcn_global_load_lds((const unsigned*)((const char*)(gbase) + (voff)[_i]), (PG8_LAS unsigned*)(lds + (bufoff) + ldsw + _i * 8192), 16, 0, 0); } while (0)
#define PG8_LDA(dst, b, h) do { _Pragma("unroll") for (int m = 0; m < 4; ++m) _Pragma("unroll") for (int k = 0; k < 2; ++k) dst[m][k] = *(const PG8_LAS bf16x8*)(lds + PG8_SA(b, h) + aoff + m * 2048 + k * 1024); } while (0)
#define PG8_LDB(dst, b, h) do { _Pragma("unroll") for (int n = 0; n < 2; ++n) _Pragma("unroll") for (int k = 0; k < 2; ++k) dst[n][k] = *(const PG8_LAS bf16x8*)(lds + PG8_SB(b, h) + boff + n * 2048 + k * 1024); } while (0)
#define PG8_MMA(ai, bj, At, Bt) do { __builtin_amdgcn_s_setprio(1); _Pragma("unroll") for (int m = 0; m < 4; ++m) _Pragma("unroll") for (int n = 0; n < 2; ++n) _Pragma("unroll") for (int k = 0; k < 2; ++k) \
        acc[ai][bj][m][n] = __builtin_amdgcn_mfma_f32_16x16x32_bf16(Bt[n][k], At[m][k], acc[ai][bj][m][n], 0, 0, 0); __builtin_amdgcn_s_setprio(0); } while (0)
#define PG8_WAIT_V(n) asm volatile("s_waitcnt vmcnt(" #n ")" ::: "memory")
#define PG8_WAIT_L(n) asm volatile("s_waitcnt lgkmcnt(" #n ")" ::: "memory")
#define PG8_BAR __builtin_amdgcn_s_barrier()
#define PG8_SCHED __builtin_amdgcn_sched_barrier(0)
    Unit cur, nxt; int ui = 0;
    if (!S.next(0, cur)) return;
    f32x4 acc[2][2][4][2];
#pragma unroll
    for (int a = 0; a < 2; ++a)
#pragma unroll
        for (int b = 0; b < 2; ++b)
#pragma unroll
            for (int m = 0; m < 4; ++m)
#pragma unroll
                for (int n = 0; n < 2; ++n) acc[a][b][m][n] = (f32x4){0.f, 0.f, 0.f, 0.f};
    bf16x8 At[4][2], B0[2][2], B1[2][2];
    const char* cA = (const char*)g.A + (size_t)cur.pm * tstep; const char* cB = (const char*)g.Bt + (size_t)cur.pn * tstep;
    S.a_ready(cur);
    if constexpr (SP2) {
        PG8_STAGE(PG8_SB(0, 0), cB, voffB); PG8_STAGE(PG8_SB(0, 1), cB + hstep, voffB); PG8_STAGE(PG8_SA(0, 0), cA, voffA); PG8_STAGE(PG8_SA(0, 1), cA + hstep, voffA);
        if (wr == 1) PG8_BAR;
        PG8_WAIT_V(2); PG8_BAR;
        PG8_STAGE(PG8_SB(1, 0), cB + kstep, voffB); PG8_STAGE(PG8_SA(1, 0), cA + kstep, voffA); PG8_STAGE(PG8_SB(1, 1), cB + hstep + kstep, voffB);
        PG8_WAIT_V(6); PG8_BAR;
    } else {
        PG8_STAGE(PG8_SB(0, 0), cB, voffB); PG8_STAGE(PG8_SA(0, 0), cA, voffA); PG8_STAGE(PG8_SB(0, 1), cB + hstep, voffB); PG8_STAGE(PG8_SA(0, 1), cA + hstep, voffA);
        if (wr == 1) PG8_BAR;
        PG8_WAIT_V(4); PG8_BAR;
        PG8_STAGE(PG8_SB(1, 0), cB + kstep, voffB); PG8_STAGE(PG8_SA(1, 0), cA + kstep, voffA); PG8_STAGE(PG8_SB(1, 1), cB + hstep + kstep, voffB);
        PG8_WAIT_V(6); PG8_BAR;
    }
    for (;;) {
        const bool has_next = S.next(ui + 1, nxt);
        const char* nA = has_next ? (const char*)g.A + (size_t)nxt.pm * tstep : cA; const char* nB = has_next ? (const char*)g.Bt + (size_t)nxt.pn * tstep : cB;
        for (int t = 0; t < nt; t += 2) {
            const bool last = (t == nt - 2);
            const char* a1 = cA + (size_t)(t + 1) * kstep;
            const char* a2 = last ? nA : cA + (size_t)(t + 2) * kstep; const char* b2 = last ? nB : cB + (size_t)(t + 2) * kstep;
            const char* a3 = a2 + kstep; const char* b3 = b2 + kstep;
            if (last && has_next) S.a_ready(nxt);
            if constexpr (SP2) {
            PG8_LDB(B0, 0, 0); PG8_LDB(B1, 0, 1); PG8_SCHED; PG8_LDA(At, 0, 0); PG8_STAGE(PG8_SA(1, 1), a1 + hstep, voffA);
            PG8_WAIT_V(8); PG8_WAIT_L(0); PG8_BAR; PG8_MMA(0, 0, At, B0); PG8_MMA(0, 1, At, B1); PG8_BAR; PG8_SCHED;
            PG8_LDA(At, 0, 1); PG8_STAGE(PG8_SB(0, 0), b2, voffB); PG8_STAGE(PG8_SB(0, 1), b2 + hstep, voffB); PG8_STAGE(PG8_SA(0, 0), a2, voffA);
            PG8_WAIT_V(8); PG8_WAIT_L(0); PG8_BAR; PG8_MMA(1, 0, At, B0); PG8_MMA(1, 1, At, B1); PG8_BAR; PG8_SCHED;
            PG8_LDB(B0, 1, 0); PG8_LDB(B1, 1, 1); PG8_SCHED; PG8_LDA(At, 1, 0); PG8_STAGE(PG8_SA(0, 1), a2 + hstep, voffA);
            PG8_WAIT_V(8); PG8_WAIT_L(0); PG8_BAR; PG8_MMA(0, 0, At, B0); PG8_MMA(0, 1, At, B1); PG8_BAR; PG8_SCHED;
            PG8_LDA(At, 1, 1); PG8_STAGE(PG8_SB(1, 0), b3, voffB); PG8_STAGE(PG8_SB(1, 1), b3 + hstep, voffB); PG8_STAGE(PG8_SA(1, 0), a3, voffA);
            PG8_WAIT_V(8); PG8_WAIT_L(0); PG8_BAR; PG8_MMA(1, 0, At, B0); PG8_MMA(1, 1, At, B1); PG8_BAR; PG8_SCHED;
            } else {
            PG8_LDB(B0, 0, 0); PG8_SCHED; PG8_LDA(At, 0, 0); PG8_STAGE(PG8_SA(1, 1), a1 + hstep, voffA);
            PG8_WAIT_L(8); PG8_BAR; PG8_WAIT_L(0); PG8_MMA(0, 0, At, B0); PG8_BAR; PG8_SCHED;
            PG8_LDB(B1, 0, 1); PG8_STAGE(PG8_SB(0, 0), b2, voffB);
            PG8_BAR; PG8_WAIT_L(0); PG8_MMA(0, 1, At, B1); PG8_BAR;
            PG8_LDA(At, 0, 1); PG8_STAGE(PG8_SA(0, 0), a2, voffA);
            PG8_BAR; PG8_WAIT_L(0); PG8_MMA(1, 0, At, B0); PG8_BAR; PG8_SCHED;
            PG8_STAGE(PG8_SB(0, 1), b2 + hstep, voffB);
            PG8_WAIT_V(6); PG8_BAR; PG8_MMA(1, 1, At, B1); PG8_BAR;
            PG8_LDB(B0, 1, 0); PG8_SCHED; PG8_LDA(At, 1, 0); PG8_STAGE(PG8_SA(0, 1), a2 + hstep, voffA);
            PG8_WAIT_L(8); PG8_BAR; PG8_WAIT_L(0); PG8_MMA(0, 0, At, B0); PG8_BAR; PG8_SCHED;
            PG8_LDB(B1, 1, 1); PG8_STAGE(PG8_SB(1, 0), b3, voffB);
            PG8_BAR; PG8_WAIT_L(0); PG8_MMA(0, 1, At, B1); PG8_BAR;
            PG8_LDA(At, 1, 1); PG8_STAGE(PG8_SA(1, 0), a3, voffA);
            PG8_BAR; PG8_WAIT_L(0); PG8_MMA(1, 0, At, B0); PG8_BAR; PG8_SCHED;
            PG8_STAGE(PG8_SB(1, 1), b3 + hstep, voffB);
            PG8_WAIT_V(6); PG8_BAR; PG8_MMA(1, 1, At, B1); PG8_BAR;
            }
        }
        if constexpr (ALIGN_EPI) { if (wr == 0) PG8_BAR; }
        if constexpr (!Epi::AFTER_DRAIN) { E(acc, cur, wr, wc, fr, fq); S.done(cur); }
        if (!has_next) break;
#pragma unroll
        for (int a = 0; a < 2; ++a)
#pragma unroll
            for (int b = 0; b < 2; ++b)
#pragma unroll
                for (int m = 0; m < 4; ++m)
#pragma unroll
                    for (int n = 0; n < 2; ++n) acc[a][b][m][n] = (f32x4){0.f, 0.f, 0.f, 0.f};
        cur = nxt; cA = nA; cB = nB; ++ui;
        if constexpr (ALIGN_EPI) { if (wr == 1) PG8_BAR; }
    }
    PG8_WAIT_V(0);
    if constexpr (!ALIGN_EPI) { if (wr == 0) PG8_BAR; }
    PG8_BAR;
    if constexpr (Epi::AFTER_DRAIN) { E.fused(acc, cur, wr, wc, fr, fq, lds, wid, lane); S.done(cur); }
#undef PG8_SA
#undef PG8_SB
#undef PG8_STAGE
#undef PG8_LDA
#undef PG8_LDB
#undef PG8_MMA
#undef PG8_WAIT_V
#undef PG8_WAIT_L
#undef PG8_BAR
#undef PG8_SCHED
}
}

constexpr int NWAVES = 8, NTHR = 512;
constexpr int DM = 2048, NTOK = 8192, NCTX = 4096, DFF = 8192, NLAYER = 4, NMODC = 12288;
constexpr float RMS_EPS = 1e-6f;
constexpr float LOG2E = 1.4426950408889634f;

constexpr size_t MiB = 1u << 20;
constexpr size_t WS_CTL = 0, CTL_ZERO_BYTES = 1 * MiB;
constexpr size_t WS_ROPE = 1 * MiB;
constexpr size_t WS_MOD = 2 * MiB;
constexpr size_t WS_MODP = 4 * MiB;
constexpr size_t WS_GATES = 12 * MiB;
constexpr size_t WS_W = 16 * MiB;
constexpr size_t W_AIN = WS_W, W_AOUT = W_AIN + 24 * MiB, W_BIN = W_AOUT + 8 * MiB, W_BOUT = W_BIN + 24 * MiB;
constexpr size_t W_CIN = W_BOUT + 8 * MiB, W_COUT = W_CIN + 24 * MiB, W_DIN = W_COUT + 8 * MiB, W_DOUT = W_DIN + 12 * MiB;
constexpr size_t W_FF1 = W_DOUT + 8 * MiB, W_FF2 = W_FF1 + 128 * MiB;
constexpr size_t WS_H = W_FF2 + 128 * MiB;
constexpr size_t WS_QKV = WS_H + 32 * MiB;
constexpr size_t WS_O = WS_QKV + 96 * MiB;
constexpr size_t WS_Y = WS_O + 32 * MiB;
constexpr size_t WS_U = WS_Y + 64 * MiB;
constexpr size_t WS_CAK = WS_U + 128 * MiB, WS_CAV = WS_CAK + 8 * MiB, WS_CCK = WS_CAV + 8 * MiB, WS_CCV = WS_CCK + 8 * MiB;
constexpr size_t WS_CDK = WS_CCV + 8 * MiB, WS_CDV = WS_CDK + 2 * MiB, WS_SC = WS_CDV + 2 * MiB;
constexpr size_t WS_END = WS_SC + 4 * MiB;
constexpr int CW_BAR = 4096;

constexpr size_t O_YP = 0, O_AK = 16777216, O_AV = 25165824, O_BC = 33554432, O_BN = 41943040, O_BM = 41975808, O_CK = 41976064, O_CV = 50364672, O_DK = 58753280, O_DV = 60850432, O_END = 62947584;

constexpr int LDS_PHASE_BYTES = 162816;
constexpr int MISC_OFF = LDS_PHASE_BYTES;
constexpr int LDS_BYTES = LDS_PHASE_BYTES + 256;

#define LAS __attribute__((address_space(3)))
#define DI __device__ __forceinline__
typedef unsigned short bf16;
typedef short bf16x8 __attribute__((ext_vector_type(8)));
typedef short s16x4 __attribute__((ext_vector_type(4)));
typedef float f32x16 __attribute__((ext_vector_type(16)));
typedef float f32x4 __attribute__((ext_vector_type(4)));
typedef float f32x2 __attribute__((ext_vector_type(2)));
typedef unsigned u32x4 __attribute__((ext_vector_type(4)));
typedef unsigned u32x2 __attribute__((ext_vector_type(2)));
typedef __bf16 bf16x2_t __attribute__((ext_vector_type(2)));
typedef LAS char* ldsp;

DI unsigned pk2(float lo, float hi) { f32x2 v = {lo, hi}; bf16x2_t b = __builtin_convertvector(v, bf16x2_t); return __builtin_bit_cast(unsigned, b); }
DI float bf2f(unsigned short v) { return __uint_as_float(((unsigned)v) << 16); }
DI float bflo(unsigned w) { return __uint_as_float(w << 16); }
DI float bfhi(unsigned w) { return __uint_as_float(w & 0xffff0000u); }
DI float ex2(float x) { return __builtin_amdgcn_exp2f(x); }
DI float wave_sum(float v) {
#pragma unroll
    for (int o = 1; o < 64; o <<= 1) v += __shfl_xor(v, o);
    return v;
}
DI float hmax(float x) { auto rr = __builtin_amdgcn_permlane32_swap(__float_as_uint(x), __float_as_uint(x), false, false); return fmaxf(__uint_as_float(rr[0]), __uint_as_float(rr[1])); }
DI float hsum(float x) { auto rr = __builtin_amdgcn_permlane32_swap(__float_as_uint(x), __float_as_uint(x), false, false); return __uint_as_float(rr[0]) + __uint_as_float(rr[1]); }
DI int crow(int r, int hi) { return (r & 3) + 8 * (r >> 2) + 4 * hi; }

#define XB_TMO      128
#define XB_XCNT(j)  (256  + 64 * (j))
#define XB_XSUB(j)  (1280 + 64 * (j))
#define XB_XGEN(j)  (2304 + 64 * (j))
#define XB_TOP      3328
#define XB_TOPGEN   3392
#define XCD_BAR_WORDS 3456
#define XB_SPIN_CAP (1u << 18)
__device__ __forceinline__ unsigned xb_ld(unsigned* p)              { return __hip_atomic_load(p, __ATOMIC_RELAXED, __HIP_MEMORY_SCOPE_AGENT); }
__device__ __forceinline__ unsigned xb_add(unsigned* p, unsigned v) { return __hip_atomic_fetch_add(p, v, __ATOMIC_RELAXED, __HIP_MEMORY_SCOPE_AGENT); }
__device__ __forceinline__ unsigned xb_xcc_id() { return (unsigned)__builtin_amdgcn_s_getreg((3 << 11) | 20) & 0xFu; }
#define XB_SPIN(cond, bar) do { unsigned _sp = 0; while (cond) { __builtin_amdgcn_s_sleep(1); \
    if ((++_sp & 255u) == 0u) { if (xb_ld(&(bar)[XB_TMO])) break; if (_sp > XB_SPIN_CAP) { atomicAdd(&(bar)[XB_TMO], 1u); break; } } } } while (0)
struct XcdBarrier { unsigned* bar; unsigned x; volatile LAS unsigned* st; };
__device__ __forceinline__ XcdBarrier xcd_barrier_post(unsigned* bar, volatile LAS unsigned* st) {
    XcdBarrier b; b.bar = bar; b.x = xb_xcc_id(); b.st = st;
    if (threadIdx.x == 0) (void)xb_add(&bar[XB_XCNT(b.x)], 1u);
    return b;
}
__device__ __forceinline__ void xcd_barrier_complete(unsigned* bar, unsigned x, unsigned& nloc, unsigned& nx) {
    const unsigned G = gridDim.x * gridDim.y * gridDim.z;
    unsigned sum, cnt, mine, sp = 0u;
    for (;;) {
        sum = 0u; cnt = 0u; mine = 0u;
#pragma unroll
        for (unsigned j = 0; j < 16; ++j) { const unsigned c = xb_ld(&bar[XB_XCNT(j)]); sum += c; cnt += (c > 0u) ? 1u : 0u; mine = (j == x) ? c : mine; }
        if (sum == G) break;
        __builtin_amdgcn_s_sleep(1);
        if ((++sp & 255u) == 0u) { if (xb_ld(&bar[XB_TMO])) break; if (sp > XB_SPIN_CAP) { atomicAdd(&bar[XB_TMO], 1u); break; } }
    }
    nloc = mine > 0u ? mine : 1u; nx = cnt > 0u ? cnt : 1u;
}
__device__ __forceinline__ void xcd_barrier(const XcdBarrier& b) {
    asm volatile("s_waitcnt vmcnt(0)" ::: "memory");
    __syncthreads();
    if (threadIdx.x == 0) {
        unsigned* bar = b.bar;
        __builtin_amdgcn_s_waitcnt(0);
        unsigned nloc = b.st[0], nx = b.st[1];
        if (nloc == 0u) { xcd_barrier_complete(bar, b.x, nloc, nx); b.st[0] = nloc; b.st[1] = nx; }
        const unsigned old = xb_add(&bar[XB_XSUB(b.x)], 1u);
        const unsigned gen = old / nloc;
        if (old + 1u == (gen + 1u) * nloc) {
            __builtin_amdgcn_fence(__ATOMIC_RELEASE, "agent");
            asm volatile("s_waitcnt vmcnt(0)" ::: "memory");
            const unsigned og = xb_add(&bar[XB_TOP], 1u);
            const unsigned tg = og / nx;
            if (og + 1u == (tg + 1u) * nx) xb_add(&bar[XB_TOPGEN], 1u);
            else XB_SPIN(xb_ld(&bar[XB_TOPGEN]) == tg, bar);
            __builtin_amdgcn_fence(__ATOMIC_ACQUIRE, "agent");
            xb_add(&bar[XB_XGEN(b.x)], 1u);
            asm volatile("s_waitcnt vmcnt(0)" ::: "memory");
        } else {
            XB_SPIN(xb_ld(&bar[XB_XGEN(b.x)]) == gen, bar);
            __builtin_amdgcn_fence(__ATOMIC_ACQUIRE, "agent");
            asm volatile("s_waitcnt vmcnt(0)" ::: "memory");
        }
    }
    __syncthreads();
}

struct Args { const float* in[32]; float* out; unsigned char* ws; int ph_lo, ph_hi; };

DI void transpose_item(const float* W, int K, int N, int ld, bf16* WT, LAS float* scr, int item, int lane) {
    const int nblk = N / 32, kb = item / nblk, nb = item % nblk, k0 = 64 * kb, n0 = 32 * nb;
    float v[32];
#pragma unroll
    for (int i = 0; i < 32; ++i) { const int kk = 2 * i + (lane >> 5); v[i] = W[(size_t)(k0 + kk) * ld + n0 + (lane & 31)]; }
#pragma unroll
    for (int i = 0; i < 32; ++i) { const int kk = 2 * i + (lane >> 5); scr[kk * 33 + (lane & 31)] = v[i]; }
    asm volatile("s_waitcnt lgkmcnt(0)" ::: "memory");
    const int c = lane & 7;
#pragma unroll
    for (int j = 0; j < 4; ++j) { const int n = (lane >> 3) + 8 * j; const LAS float* s = scr + (8 * c) * 33 + n;
        u32x4 o; o.x = pk2(s[0 * 33], s[1 * 33]); o.y = pk2(s[2 * 33], s[3 * 33]); o.z = pk2(s[4 * 33], s[5 * 33]); o.w = pk2(s[6 * 33], s[7 * 33]);
        *(u32x4*)(WT + (size_t)(n0 + n) * K + k0 + 8 * c) = o; }
    asm volatile("s_waitcnt lgkmcnt(0)" ::: "memory");
}
DI void cvt_flat(const float* src, bf16* dst, size_t n8, size_t gtid, size_t nthr) {
    for (size_t i = gtid; i < n8; i += nthr) { const f32x4 a = *(const f32x4*)(src + i * 8), b = *(const f32x4*)(src + i * 8 + 4);
        u32x4 o; o.x = pk2(a[0], a[1]); o.y = pk2(a[2], a[3]); o.z = pk2(b[0], b[1]); o.w = pk2(b[2], b[3]); *(u32x4*)(dst + i * 8) = o; }
}
DI float silu(float x) { return x / (1.f + __expf(-x)); }

DI void p0a_prologue(const Args& A, ldsp lds, int G, int bid, int tid) {
    const int lane = tid & 63, wave = tid >> 6;
    unsigned char* ws = A.ws;
    const int gw = bid * NWAVES + wave, NGW = G * NWAVES;
    LAS float* scr = (LAS float*)(lds + wave * 16384);
    constexpr int I_IN = (DM / 64) * (6144 / 32), I_OUT = (DM / 64) * (DM / 32), I_DIN = (DM / 64) * (3072 / 32), I_F1 = (DM / 64) * (DFF / 32), I_F2 = (DFF / 64) * (DM / 32);
    constexpr int NITEMS = 3 * I_IN + 4 * I_OUT + I_DIN + 4 * I_F1 + 4 * I_F2;
    for (int it = gw; it < NITEMS; it += NGW) {
        int r = it;
        if (r < I_IN) { transpose_item(A.in[18], DM, 6144, 6144, (bf16*)(ws + W_AIN), scr, r, lane); continue; } r -= I_IN;
        if (r < I_OUT) { transpose_item(A.in[19], DM, DM, DM, (bf16*)(ws + W_AOUT), scr, r, lane); continue; } r -= I_OUT;
        if (r < I_IN) { transpose_item(A.in[22], DM, 6144, 6176, (bf16*)(ws + W_BIN), scr, r, lane); continue; } r -= I_IN;
        if (r < I_OUT) { transpose_item(A.in[24], DM, DM, DM, (bf16*)(ws + W_BOUT), scr, r, lane); continue; } r -= I_OUT;
        if (r < I_IN) { transpose_item(A.in[26], DM, 6144, 6144, (bf16*)(ws + W_CIN), scr, r, lane); continue; } r -= I_IN;
        if (r < I_OUT) { transpose_item(A.in[27], DM, DM, DM, (bf16*)(ws + W_COUT), scr, r, lane); continue; } r -= I_OUT;
        if (r < I_DIN) { transpose_item(A.in[29], DM, 3072, 3072, (bf16*)(ws + W_DIN), scr, r, lane); continue; } r -= I_DIN;
        if (r < I_OUT) { transpose_item(A.in[30], DM, DM, DM, (bf16*)(ws + W_DOUT), scr, r, lane); continue; } r -= I_OUT;
        if (r < 4 * I_F1) { const int L = r / I_F1; r -= L * I_F1;
            transpose_item(A.in[16] + (size_t)L * DM * DFF, DM, DFF, DFF, (bf16*)(ws + W_FF1) + (size_t)L * DM * DFF, scr, r, lane); continue; } r -= 4 * I_F1;
        { const int L = r / I_F2; r -= L * I_F2;
            transpose_item(A.in[17] + (size_t)L * DM * DFF, DFF, DM, DM, (bf16*)(ws + W_FF2) + (size_t)L * DM * DFF, scr, r, lane); }
    }
    const size_t gtid = (size_t)bid * NTHR + tid, nthr = (size_t)G * NTHR;
    cvt_flat(A.in[2], (bf16*)(ws + WS_CAK), (size_t)4 * 512 * 2048 / 8, gtid, nthr);
    cvt_flat(A.in[3], (bf16*)(ws + WS_CAV), (size_t)4 * 512 * 2048 / 8, gtid, nthr);
    cvt_flat(A.in[7], (bf16*)(ws + WS_CCK), (size_t)4 * 512 * 2048 / 8, gtid, nthr);
    cvt_flat(A.in[8], (bf16*)(ws + WS_CCV), (size_t)4 * 512 * 2048 / 8, gtid, nthr);
    cvt_flat(A.in[9], (bf16*)(ws + WS_CDK), (size_t)4 * 512 * 512 / 8, gtid, nthr);
    cvt_flat(A.in[10], (bf16*)(ws + WS_CDV), (size_t)4 * 512 * 512 / 8, gtid, nthr);
    cvt_flat(A.in[4], (bf16*)(ws + WS_SC), (size_t)4 * 2 * 8 * 256 * 128 / 8, gtid, nthr);
    if (gtid < 1024) {
        const int pos = (int)gtid >> 4, i = (int)gtid & 15;
        double inv = 1.0; for (int k = 0; k < i; ++k) inv *= 0.5623413251903491;
        const double rev = (double)pos * inv * 0.15915494309189535;
        const double fr = rev - floor(rev);
        float* rt = (float*)(ws + WS_ROPE);
        rt[gtid * 2] = __builtin_amdgcn_cosf((float)fr); rt[gtid * 2 + 1] = __builtin_amdgcn_sinf((float)fr);
    }
    float* modp = (float*)(ws + WS_MODP);
    for (int un = gw; un < 4 * 48 * 8; un += NGW) {
        const int L = un / 384, rem = un % 384, cb = rem >> 3, ks = rem & 7;
        const float* wm = A.in[13] + ((size_t)L * DM + ks * 256) * NMODC + cb * 256 + lane * 4;
        f32x4 acc[5];
#pragma unroll
        for (int c = 0; c < 5; ++c) acc[c] = (f32x4){0.f, 0.f, 0.f, 0.f};
#pragma unroll 8
        for (int k = 0; k < 256; ++k) {
            const f32x4 w = *(const f32x4*)(wm + (size_t)k * NMODC);
            const int kk = ks * 256 + k;
            const float s0 = silu(A.in[12][kk]);
            acc[0] += w * s0;
#pragma unroll
            for (int c = 1; c < 5; ++c) { const float s = silu(A.in[11][(c - 1) * DM + kk]); acc[c] += w * s; }
        }
#pragma unroll
        for (int c = 0; c < 5; ++c) *(f32x4*)(modp + ((size_t)(L * 8 + ks) * 5 + c) * NMODC + cb * 256 + lane * 4) = acc[c];
    }
}
DI void p0b_modreduce(const Args& A, int G, int bid, int tid) {
    const float* modp = (const float*)(A.ws + WS_MODP); float* mod = (float*)(A.ws + WS_MOD);
    for (int i = bid * NTHR + tid; i < 4 * 5 * NMODC; i += G * NTHR) {
        const int L = i / (5 * NMODC), rem = i % (5 * NMODC), c = rem / NMODC, col = rem % NMODC;
        float s = A.in[14][L * NMODC + col];
#pragma unroll
        for (int ks = 0; ks < 8; ++ks) s += modp[((size_t)(L * 8 + ks) * 5 + c) * NMODC + col];
        mod[i] = s;
    }
}

struct RowP {
    const bf16* Y;
    int mod_gate;
    int Lg;
    int gpost;
    int has_next;
    int Ln;
    int gpre;
    int mod_shift;
    int do_gates;
    int dry;
};
DI void row_load(const Args& A, const RowP& P, int r, int lane, f32x4 (&x)[8], u32x2 (&yw)[8]) {
    const float* src = P.Y == nullptr ? (r < NCTX ? A.in[0] + (size_t)r * DM : A.in[1] + (size_t)(r - NCTX) * DM) : A.out + (size_t)r * DM;
#pragma unroll
    for (int j = 0; j < 8; ++j) x[j] = *(const f32x4*)(src + 4 * lane + 256 * j);
    if (P.Y != nullptr) {
#pragma unroll
        for (int j = 0; j < 8; ++j) yw[j] = *(const u32x2*)(P.Y + (size_t)r * DM + 4 * lane + 256 * j);
    }
}
DI void row_proc(const Args& A, const RowP& P, ldsp lds, int r, int slot, int lane, int wave, f32x4 (&x)[8], const u32x2 (&yw)[8]) {
    bf16* H = (bf16*)(A.ws + WS_H);
    float* Xw = P.dry ? (float*)(A.ws + WS_U) : A.out; bf16* Hw = P.dry ? (bf16*)(A.ws + WS_U + 64 * MiB) : H;
    const float* mod = (const float*)(A.ws + WS_MOD); const float* gn = A.in[15];
    const int cond = r < NCTX ? 0 : 1 + ((r - NCTX) >> 10);
    if (P.Y != nullptr) {
        f32x4 y[8]; float ss = 0.f;
#pragma unroll
        for (int j = 0; j < 8; ++j) { y[j] = (f32x4){bflo(yw[j].x), bfhi(yw[j].x), bflo(yw[j].y), bfhi(yw[j].y)}; ss += (y[j][0] * y[j][0] + y[j][1] * y[j][1]) + (y[j][2] * y[j][2] + y[j][3] * y[j][3]); }
        const float rs = 1.0f / sqrtf(wave_sum(ss) * (1.f / DM) + RMS_EPS);
        const float* gate = mod + ((size_t)(P.Lg * 5 + cond) * 6 + P.mod_gate) * DM; const float* gp = gn + (size_t)P.gpost * DM;
#pragma unroll
        for (int j = 0; j < 8; ++j) { const f32x4 gt = *(const f32x4*)(gate + 4 * lane + 256 * j), gg = *(const f32x4*)(gp + 4 * lane + 256 * j);
            x[j] = x[j] + gt * (y[j] * rs * gg); }
    }
#pragma unroll
    for (int j = 0; j < 8; ++j) *(f32x4*)(Xw + (size_t)r * DM + 4 * lane + 256 * j) = x[j];
    if (P.has_next) {
        float ss = 0.f;
#pragma unroll
        for (int j = 0; j < 8; ++j) ss += (x[j][0] * x[j][0] + x[j][1] * x[j][1]) + (x[j][2] * x[j][2] + x[j][3] * x[j][3]);
        const float rs = 1.0f / sqrtf(wave_sum(ss) * (1.f / DM) + RMS_EPS);
        const float* sh = mod + ((size_t)(P.Ln * 5 + cond) * 6 + P.mod_shift) * DM; const float* sc = sh + DM; const float* gp = gn + (size_t)P.gpre * DM;
#pragma unroll
        for (int j = 0; j < 8; ++j) { const f32x4 gg = *(const f32x4*)(gp + 4 * lane + 256 * j), s1 = *(const f32x4*)(sc + 4 * lane + 256 * j), s0 = *(const f32x4*)(sh + 4 * lane + 256 * j);
            x[j] = (x[j] * rs * gg) * (1.0f + s1) + s0;
            u32x2 o; o.x = pk2(x[j][0], x[j][1]); o.y = pk2(x[j][2], x[j][3]);
            *(u32x2*)(Hw + (size_t)r * DM + 4 * lane + 256 * j) = o; }
            if (P.do_gates && !P.dry && lane == 0) ((LAS float*)(lds + 147456))[slot] = rs;
    }
}
DI float reduce32(float (&a)[32], int lane) {
#pragma unroll
    for (int i = 0; i < 16; ++i) { const bool hi = lane & 32; const float keep = hi ? a[i + 16] : a[i], send = hi ? a[i] : a[i + 16]; a[i] = keep + __shfl_xor(send, 32); }
#pragma unroll
    for (int i = 0; i < 8; ++i) { const bool hi = lane & 16; const float keep = hi ? a[i + 8] : a[i], send = hi ? a[i] : a[i + 8]; a[i] = keep + __shfl_xor(send, 16); }
#pragma unroll
    for (int i = 0; i < 4; ++i) { const bool hi = lane & 8; const float keep = hi ? a[i + 4] : a[i], send = hi ? a[i] : a[i + 4]; a[i] = keep + __shfl_xor(send, 8); }
#pragma unroll
    for (int i = 0; i < 2; ++i) { const bool hi = lane & 4; const float keep = hi ? a[i + 2] : a[i], send = hi ? a[i] : a[i + 2]; a[i] = keep + __shfl_xor(send, 4); }
    { const bool hi = lane & 2; const float keep = hi ? a[1] : a[0], send = hi ? a[0] : a[1]; a[0] = keep + __shfl_xor(send, 2); }
    return a[0] + __shfl_xor(a[0], 1);
}
DI void row_phase(const Args& A, const RowP& P, ldsp lds, int G, int bid, int tid) {
    const int lane = tid & 63, wave = tid >> 6;
    const int gw = bid * NWAVES + wave, NGW = G * NWAVES;
    int k = 0;
    for (int r = gw; r < NTOK; r += 2 * NGW, k += 2) {
        f32x4 xa[8], xb[8]; u32x2 ya[8], yb[8];
        const int r2 = r + NGW;
        row_load(A, P, r, lane, xa, ya);
        if (r2 < NTOK) row_load(A, P, r2, lane, xb, yb);
        row_proc(A, P, lds, r, (wave * 4 + k) & 31, lane, wave, xa, ya);
        if (r2 < NTOK) row_proc(A, P, lds, r2, (wave * 4 + k + 1) & 31, lane, wave, xb, yb);
    }
    if (P.do_gates && !P.dry && NTOK <= 4 * NGW) {
        LAS float* Wl = (LAS float*)lds; LAS float* rsl = (LAS float*)(lds + 147456); LAS float* gpl = rsl + 32;
        const float* Wg = A.in[22] + 6144; const float* mod = (const float*)(A.ws + WS_MOD); const float* gn = A.in[15];
        asm volatile("s_waitcnt vmcnt(0)" ::: "memory");
        __syncthreads();
        for (int half = 0; half < 2; ++half) {
            { f32x4 t[16];
#pragma unroll
              for (int i = 0; i < 16; ++i) { const int idx = tid + NTHR * i, c = idx >> 3, q = idx & 7; t[i] = *(const f32x4*)(Wg + (size_t)(half * 1024 + c) * 6176 + 4 * q); }
#pragma unroll
              for (int i = 0; i < 16; ++i) { const int idx = tid + NTHR * i, c = idx >> 3, q = idx & 7; *(LAS f32x4*)(Wl + c * 36 + 4 * q) = t[i]; } }
            __syncthreads();
            for (int kk = 0; kk < 4; ++kk) {
                const int r = gw + kk * NGW;
                if (r < NTOK) {
                    const int cond = r < NCTX ? 0 : 1 + ((r - NCTX) >> 10);
                    const float rs = rsl[wave * 4 + kk];
                    const float* xr = A.out + (size_t)r * DM + half * 1024; const float* gpv = gn + (size_t)P.gpre * DM + half * 1024;
                    const float* sh = mod + ((size_t)(P.Ln * 5 + cond) * 6 + P.mod_shift) * DM + half * 1024; const float* sc = sh + DM;
                    f32x4 av[8];
#pragma unroll
                    for (int q = 0; q < 8; ++q) av[q] = (f32x4){0.f, 0.f, 0.f, 0.f};
                    float hv[16];
#pragma unroll
                    for (int i = 0; i < 16; ++i) hv[i] = __hip_atomic_load(xr + lane + 64 * i, __ATOMIC_RELAXED, __HIP_MEMORY_SCOPE_AGENT);
#pragma unroll
                    for (int i = 0; i < 16; ++i) { const int c = lane + 64 * i; hv[i] = (hv[i] * rs * gpv[c]) * (1.0f + sc[c]) + sh[c]; }
#pragma unroll
                    for (int i = 0; i < 16; ++i) { const LAS f32x4* wrow = (const LAS f32x4*)(Wl + (lane + 64 * i) * 36);
#pragma unroll
                        for (int q = 0; q < 8; ++q) av[q] += wrow[q] * hv[i]; }
                    float acc[32];
#pragma unroll
                    for (int q = 0; q < 8; ++q) { acc[4 * q] = av[q][0]; acc[4 * q + 1] = av[q][1]; acc[4 * q + 2] = av[q][2]; acc[4 * q + 3] = av[q][3]; }
                    const float tot = reduce32(acc, lane); const int g = (lane >> 1) & 31;
                    if ((lane & 1) == 0) { if (half == 0) gpl[(wave * 4 + kk) * 32 + g] = tot; else ((float*)(A.ws + WS_GATES))[(size_t)r * 32 + g] = gpl[(wave * 4 + kk) * 32 + g] + tot + A.in[23][g]; }
                }
            }
            __syncthreads();
        }
    }
}

typedef short v4i16_t __attribute__((ext_vector_type(4)));
DI s16x4 tr_read(ldsp p) { return __builtin_bit_cast(s16x4, __builtin_amdgcn_ds_read_tr16_b64_v4i16((LAS v4i16_t*)p)); }
template <int OFF> DI s16x4 tr_asm(unsigned addr) { s16x4 r; asm volatile("ds_read_b64_tr_b16 %0, %1 offset:%2" : "=&v"(r) : "v"(addr), "i"(OFF) : "memory"); return r; }
#define MFMA32(a, b, c) __builtin_amdgcn_mfma_f32_32x32x16_bf16((a), (b), (c), 0, 0, 0)

template <int NS> DI void qk_tile(f32x16& s, ldsp kaddr, const bf16x8 (&qr)[NS]) {
#pragma unroll
    for (int i = 0; i < 16; ++i) s[i] = 0.f;
#pragma unroll
    for (int d0 = 0; d0 < NS; ++d0) { const bf16x8 a = *(const LAS bf16x8*)(kaddr + 32 * d0); s = MFMA32(a, qr[d0], s); }
}
template <int NS> DI void qk_tile_lq(f32x16& s, ldsp kaddr, ldsp qaddr) {
#pragma unroll
    for (int i = 0; i < 16; ++i) s[i] = 0.f;
#pragma unroll
    for (int d0 = 0; d0 < NS; ++d0) { const bf16x8 a = *(const LAS bf16x8*)(kaddr + 32 * d0); const bf16x8 b = *(const LAS bf16x8*)(qaddr + 32 * d0); s = MFMA32(a, b, s); }
}
template <int S> DI bf16x8 pack8(const f32x16& p) {
    u32x4 w; w.x = pk2(p[8 * S + 0], p[8 * S + 1]); w.y = pk2(p[8 * S + 2], p[8 * S + 3]); w.z = pk2(p[8 * S + 4], p[8 * S + 5]); w.w = pk2(p[8 * S + 6], p[8 * S + 7]);
    return __builtin_bit_cast(bf16x8, w);
}
template <int ND> DI void pv_tile(f32x16 (&o)[ND], ldsp vaddr, int pvb, bf16x8 p0, bf16x8 p1) {
#pragma unroll
    for (int d0 = 0; d0 < ND; ++d0) {
        const s16x4 l0 = tr_read(vaddr + 64 * d0), h0 = tr_read(vaddr + 8 * pvb + 64 * d0);
        const s16x4 l1 = tr_read(vaddr + 16 * pvb + 64 * d0), h1 = tr_read(vaddr + 24 * pvb + 64 * d0);
        const bf16x8 a0 = {l0[0], l0[1], l0[2], l0[3], h0[0], h0[1], h0[2], h0[3]};
        const bf16x8 a1 = {l1[0], l1[1], l1[2], l1[3], h1[0], h1[1], h1[2], h1[3]};
        o[d0] = MFMA32(a0, p0, o[d0]);
        o[d0] = MFMA32(a1, p1, o[d0]);
    }
}
template <int NC> DI void stage_ld(bf16x8 (&r)[NC / 64], const bf16* src, size_t gs, int tid) {
#pragma unroll
    for (int i = 0; i < NC / 64; ++i) { const int idx = tid + NTHR * i, row = idx / (NC / 8), c8 = idx % (NC / 8); r[i] = *(const bf16x8*)(src + (size_t)row * gs + c8 * 8); }
}
template <int NC> DI void stage_st(const bf16x8 (&r)[NC / 64], ldsp dst, int pb, int tid) {
#pragma unroll
    for (int i = 0; i < NC / 64; ++i) { const int idx = tid + NTHR * i, row = idx / (NC / 8), c8 = idx % (NC / 8); *(LAS bf16x8*)(dst + row * pb + c8 * 16) = r[i]; }
}

template <int RB> DI int fK(int row) { return RB == 128 ? ((row >> 1) & 7) : (row & 15); }
template <int RB> DI int fV(int row) { return RB == 128 ? (((row >> 1) & 1) << 2) : ((row & 3) << 2); }
template <int RB, bool ISV> DI void dma_tile(ldsp dst, const bf16* src, size_t gs, int wave, int lane) {
    constexpr int NI = 64 * RB / 1024 / 8, SPR = RB / 16, RPP = 1024 / RB;
    const int pos = wave * 64 + lane, row = pos / SPR, sl = pos % SPR, g = sl ^ (ISV ? fV<RB>(row) : fK<RB>(row));
    const bf16* lp = src + (size_t)row * gs + g * 8;
#pragma unroll
    for (int i = 0; i < NI; ++i)
        __builtin_amdgcn_global_load_lds((const unsigned*)(lp + (size_t)(8 * i * RPP) * gs), (LAS unsigned*)(dst + (wave + 8 * i) * 1024), 16, 0, 0);
}
#define VM_WAIT_N(n) asm volatile("s_waitcnt vmcnt(" #n ")" ::: "memory")
template <int PIECES> DI void wait_chunks(int rem) {
    if (rem >= 2) { if constexpr (PIECES == 2) VM_WAIT_N(4); else if constexpr (PIECES == 4) VM_WAIT_N(8); else VM_WAIT_N(12); }
    else if (rem == 1) { if constexpr (PIECES == 2) VM_WAIT_N(2); else if constexpr (PIECES == 4) VM_WAIT_N(4); else VM_WAIT_N(6); }
    else VM_WAIT_N(0);
}

template <int DQK, int KW, int DV, class Pol>
DI void attn_loop(ldsp lds, const Pol& P, const bf16x8 (&qr)[DQK / 16], f32x16 (&o)[DV / 32], float& m, float& l, int tid) {
    constexpr int RBK = KW * 2, RBV = DV * 2, KBYTES = 64 * RBK, VBYTES = 64 * RBV, BUF = KBYTES + VBYTES, NS = 4, PD = 3;
    constexpr int PIECES = (KBYTES + VBYTES) / 8192;
    const int lane = tid & 63, wave = __builtin_amdgcn_readfirstlane(tid >> 6), r32 = lane & 31, h2 = lane >> 5, i16 = lane & 15, tq = i16 >> 2, tp = i16 & 3, blk = (lane >> 4) & 1;
    const int kx = fK<RBK>(r32), kg0 = P.kcol / 8 + h2;
    const int krow = r32 * RBK;
    const int vbase = (4 * h2 + tq) * RBV + 32 * blk + 8 * tp;
    const int vx = RBV == 128 ? (tq >> 1) : tq;
    const int n = P.nchunks;
    asm volatile("s_waitcnt vmcnt(0) lgkmcnt(0)" ::: "memory");
#pragma unroll
    for (int k = 0; k < PD; ++k) if (k < n) { const bf16 *kp, *vp; size_t st; P.src(k, kp, vp, st); ldsp sb = lds + k * BUF; dma_tile<RBK, false>(sb, kp, st, wave, lane); dma_tile<RBV, true>(sb + KBYTES, vp, st, wave, lane); }
    for (int c = 0; c < n; ++c) {
        wait_chunks<PIECES>(n - 1 - c < PD - 1 ? n - 1 - c : PD - 1);
        __builtin_amdgcn_s_barrier(); asm volatile("" ::: "memory");
        if (c + PD < n) { const bf16 *kp, *vp; size_t st; P.src(c + PD, kp, vp, st); ldsp sb = lds + ((c + PD) & (NS - 1)) * BUF; dma_tile<RBK, false>(sb, kp, st, wave, lane); dma_tile<RBV, true>(sb + KBYTES, vp, st, wave, lane); }
        ldsp kb = lds + (c & (NS - 1)) * BUF; ldsp vb = kb + KBYTES;
        if (P.active(c)) {
#pragma unroll
            for (int kt = 0; kt < 2; ++kt) {
                f32x16 s0;
#pragma unroll
                for (int i = 0; i < 16; ++i) s0[i] = 0.f;
#pragma unroll
                for (int d0 = 0; d0 < DQK / 16; ++d0) { const bf16x8 a = *(const LAS bf16x8*)(kb + 32 * kt * RBK + krow + (((kg0 + 2 * d0) ^ kx) << 4)); s0 = MFMA32(a, qr[d0], s0); }
                P.fix(c, kt, s0);
                float mx = s0[0];
#pragma unroll
                for (int r = 1; r < 16; ++r) mx = fmaxf(mx, s0[r]);
                mx = hmax(mx) * P.sc2;
                if (!__all(mx - m <= 8.0f)) {
                    const float mn = fmaxf(m, mx), alpha = ex2(m - mn); m = mn; l *= alpha;
#pragma unroll
                    for (int d0 = 0; d0 < DV / 32; ++d0)
#pragma unroll
                        for (int r = 0; r < 16; ++r) o[d0][r] *= alpha;
                }
                float ps = 0.f;
#pragma unroll
                for (int r = 0; r < 16; ++r) { s0[r] = ex2(fmaf(s0[r], P.sc2, -m)); ps += s0[r]; }
                l += hsum(ps);
                const bf16x8 p0 = pack8<0>(s0), p1 = pack8<1>(s0);
                const unsigned va0 = (unsigned)(__UINTPTR_TYPE__)vb + (unsigned)((32 * kt) * RBV + vbase);
#pragma unroll
                for (int dp = 0; dp < DV / 64; ++dp) {
                    const unsigned a = va0 + 64 * ((2 * dp) ^ vx), b = va0 + 64 * ((2 * dp + 1) ^ vx);
                    const s16x4 l0 = tr_asm<0>(a), h0 = tr_asm<8 * RBV>(a), l1 = tr_asm<16 * RBV>(a), h1 = tr_asm<24 * RBV>(a);
                    const s16x4 m0 = tr_asm<0>(b), n0 = tr_asm<8 * RBV>(b), m1 = tr_asm<16 * RBV>(b), n1 = tr_asm<24 * RBV>(b);
                    asm volatile("s_waitcnt lgkmcnt(0)" ::: "memory"); __builtin_amdgcn_sched_barrier(0);
                    const bf16x8 a0 = {l0[0], l0[1], l0[2], l0[3], h0[0], h0[1], h0[2], h0[3]};
                    const bf16x8 a1 = {l1[0], l1[1], l1[2], l1[3], h1[0], h1[1], h1[2], h1[3]};
                    const bf16x8 b0 = {m0[0], m0[1], m0[2], m0[3], n0[0], n0[1], n0[2], n0[3]};
                    const bf16x8 b1 = {m1[0], m1[1], m1[2], m1[3], n1[0], n1[1], n1[2], n1[3]};
                    o[2 * dp] = MFMA32(a0, p0, o[2 * dp]);
                    o[2 * dp + 1] = MFMA32(b0, p0, o[2 * dp + 1]);
                    o[2 * dp] = MFMA32(a1, p1, o[2 * dp]);
                    o[2 * dp + 1] = MFMA32(b1, p1, o[2 * dp + 1]);
                }
            }
        }
    }
    asm volatile("s_waitcnt lgkmcnt(0)" ::: "memory"); __builtin_amdgcn_s_barrier(); asm volatile("" ::: "memory");
}
template <int ND> DI void store_ot(const f32x16 (&o)[ND], float inv, bf16* orow, int h2) {
#pragma unroll
    for (int d0 = 0; d0 < ND; ++d0)
#pragma unroll
        for (int g = 0; g < 4; ++g) { u32x2 w; w.x = pk2(o[d0][4 * g] * inv, o[d0][4 * g + 1] * inv); w.y = pk2(o[d0][4 * g + 2] * inv, o[d0][4 * g + 3] * inv);
            *(u32x2*)(orow + 32 * d0 + 8 * g + 4 * h2) = w; }
}

struct PolA {
    static constexpr float sc2 = 0.125f * LOG2E;
    int nchunks, kcol; const bf16* QKV; const bf16* CK; const bf16* CV; int b, h, latent;
    DI void src(int c, const bf16*& kp, const bf16*& vp, size_t& st) const {
        if (latent && c < 8) { const size_t off = ((size_t)(b * 512 + 64 * c) * 16 + h) * 128; kp = CK + off; vp = CV + off; st = 2048; }
        else { const int row = latent ? NCTX + b * 1024 + 64 * (c - 8) : b * 256 + 64 * c; kp = QKV + (size_t)row * 6144 + 2048 + h * 128; vp = kp + 2048; st = 6144; }
    }
    DI bool active(int) const { return true; }
    DI void fix(int, int, f32x16&) const {}
};
DI void phaseA(const Args& A, ldsp lds, int G, int bid, int tid) {
    const int lane = tid & 63, wave = tid >> 6, r32 = lane & 31, h2 = lane >> 5, j = wave >> 2, wq = wave & 3;
    const bf16* QKV = (const bf16*)(A.ws + WS_QKV); bf16* O = (bf16*)(A.ws + WS_O);
    const float lam_init = 0.2f;
    LAS float* xb = (LAS float*)lds;
    for (int u = bid; u < 1024; u += G) {
        PolA P; P.QKV = QKV; P.CK = (const bf16*)(A.ws + WS_CAK); P.CV = (const bf16*)(A.ws + WS_CAV); P.kcol = 64 * j;
        int rowbase;
        if (u < 512) { const int uu = (G == 256) ? ((((u >> 8) * 128 + (bid & 7) * 16 + (bid >> 4)) << 1) | ((bid >> 3) & 1)) : u;
            P.latent = 0; P.b = uu >> 5; P.h = (uu >> 1) & 15; P.nchunks = 4; rowbase = P.b * 256 + (uu & 1) * 128; }
        else { const int v0 = u - 512; const int v = (G == 256) ? ((((v0 >> 8) * 32 + (bid & 7) * 4 + (bid >> 6)) << 3) | ((bid >> 3) & 7)) : v0;
            P.latent = 1; P.b = v >> 7; P.h = (v >> 3) & 15; P.nchunks = 24; rowbase = NCTX + P.b * 1024 + (v & 7) * 128; }
        { const int rep = 1;
        const int row = rowbase + 32 * wq + r32;
        bf16x8 qr[4];
#pragma unroll
        for (int d0 = 0; d0 < 4; ++d0) qr[d0] = *(const bf16x8*)(QKV + (size_t)row * 6144 + P.h * 128 + j * 64 + 16 * d0 + 8 * h2);
        f32x16 o[4];
#pragma unroll
        for (int d0 = 0; d0 < 4; ++d0)
#pragma unroll
            for (int r = 0; r < 16; ++r) o[d0][r] = 0.f;
        float m = -1e30f, l = 0.f;
        asm volatile("s_waitcnt vmcnt(0)" ::: "memory");
#pragma unroll
        for (int d0 = 0; d0 < 4; ++d0) asm volatile("" : "+v"(qr[d0]));
        asm volatile("" : "+v"(m));
        if (rep == 1) attn_loop<64, 128, 128, PolA>(lds, P, qr, o, m, l, tid);
        const float inv = 1.0f / l;
        if (j == 1) {
#pragma unroll
            for (int d0 = 0; d0 < 4; ++d0)
#pragma unroll
                for (int r = 0; r < 16; ++r) xb[((wq * 4 + d0) * 16 + r) * 64 + lane] = o[d0][r] * inv;
        }
        __syncthreads();
        if (j == 0) {
            const float* lp = A.in[20];
            const float d1 = wave_sum(lp[(0 * 16 + P.h) * 64 + lane] * lp[(1 * 16 + P.h) * 64 + lane]);
            const float d2 = wave_sum(lp[(2 * 16 + P.h) * 64 + lane] * lp[(3 * 16 + P.h) * 64 + lane]);
            const float lam = __expf(d1) - __expf(d2) + lam_init;
            float ss = 0.f;
#pragma unroll
            for (int d0 = 0; d0 < 4; ++d0)
#pragma unroll
                for (int r = 0; r < 16; ++r) { const float v = o[d0][r] * inv - lam * xb[((wq * 4 + d0) * 16 + r) * 64 + lane]; o[d0][r] = v; ss += v * v; }
            ss = hsum(ss);
            const float rs = (1.0f / sqrtf(ss * (1.f / 128.f) + RMS_EPS)) * (1.0f - lam_init);
            const float* sub = A.in[21];
#pragma unroll
            for (int d0 = 0; d0 < 4; ++d0)
#pragma unroll
                for (int r = 0; r < 16; ++r) o[d0][r] *= sub[32 * d0 + crow(r, h2)];
            store_ot<4>(o, rs, O + (size_t)row * DM + P.h * 128, h2);
        }
        __syncthreads();
        }
    }
}

struct PolC {
    static constexpr float sc2 = 0.08838834764831845f * LOG2E;
    int nchunks, kcol; const bf16* QKV; const bf16* CK; const bf16* CV; int b, h, latent;
    int nb, krlo, r, r0, qc, cstart; const LAS float* rpb;
    DI void src(int c, const bf16*& kp, const bf16*& vp, size_t& st) const {
        if (latent && c >= nb) { const size_t off = ((size_t)(b * 512 + 64 * (c - nb)) * 16 + h) * 128; kp = CK + off; vp = CV + off; st = 2048; }
        else { const int row = latent ? NCTX + b * 1024 + 64 * (krlo + c) : b * 256 + 64 * c; kp = QKV + (size_t)row * 6144 + 2048 + h * 128; vp = kp + 2048; st = 6144; }
    }
    DI bool active(int c) const { return !latent || c >= nb || (krlo + c >= r0 && krlo + c < r0 + 8); }
    DI void fix(int c, int kt, f32x16& s) const {
        if (latent && c < nb) {
            int h2 = (threadIdx.x >> 5) & 1; asm volatile("" : "+v"(h2));
            const int kr = krlo + c;
            int drow = kr - r + 7; drow = drow < 0 ? 0 : (drow > 14 ? 14 : drow);
#pragma unroll
            for (int rr = 0; rr < 16; ++rr) { const int kc = 32 * kt + crow(rr, h2); const bool ok = (kc >= cstart) && (kc < cstart + 16);
                int dc = kc - qc + 15; dc = dc < 0 ? 0 : (dc > 30 ? 30 : dc);
                const float bias = rpb[drow * 31 + dc];
                s[rr] = ok ? s[rr] + bias : -INFINITY; }
        }
    }
};
DI void phaseC(const Args& A, ldsp lds, int G, int bid, int tid) {
    const int lane = tid & 63, wave = __builtin_amdgcn_readfirstlane(tid >> 6), r32 = lane & 31, h2 = lane >> 5;
    const bf16* QKV = (const bf16*)(A.ws + WS_QKV); bf16* O = (bf16*)(A.ws + WS_O);
    LAS float* rpbL = (LAS float*)(lds + 4 * 32768);
    for (int u = bid; u < 512; u += G) {
        PolC P; P.QKV = QKV; P.CK = (const bf16*)(A.ws + WS_CCK); P.CV = (const bf16*)(A.ws + WS_CCV); P.kcol = 0; P.rpb = rpbL;
        int row;
        if (u < 256) { P.latent = 0; P.b = u >> 4; P.h = u & 15; P.nchunks = 4; row = P.b * 256 + 32 * wave + r32; P.nb = 0; P.krlo = 0; P.r = 0; P.r0 = 0; P.qc = 0; P.cstart = 0; }
        else { const int v0 = u - 256; const int v = (G == 256) ? ((((bid & 7) * 8 + (bid >> 5)) << 2) | ((bid >> 3) & 3)) : v0;
            P.latent = 1; P.b = v >> 6; P.h = (v >> 2) & 15; const int R4 = v & 3;
            const int rlo = 4 * R4, rhi = 4 * R4 + 3;
            const int r0lo = rlo - 4 < 0 ? 0 : (rlo - 4 > 8 ? 8 : rlo - 4), r0hi = rhi - 4 < 0 ? 0 : (rhi - 4 > 8 ? 8 : rhi - 4);
            P.krlo = r0lo; P.nb = r0hi + 8 - r0lo; P.nchunks = P.nb + 8;
            P.r = rlo + (wave >> 1); P.r0 = P.r - 4 < 0 ? 0 : (P.r - 4 > 8 ? 8 : P.r - 4);
            P.qc = 32 * (wave & 1) + r32; P.cstart = P.qc - 8 < 0 ? 0 : (P.qc - 8 > 48 ? 48 : P.qc - 8);
            row = NCTX + P.b * 1024 + P.r * 64 + P.qc;
            for (int i = tid; i < 15 * 31; i += NTHR) rpbL[i] = A.in[28][(size_t)P.h * 465 + i] * 11.313708498984761f;
        }
        bf16x8 qr[8];
#pragma unroll
        for (int d0 = 0; d0 < 8; ++d0) qr[d0] = *(const bf16x8*)(QKV + (size_t)row * 6144 + P.h * 128 + 16 * d0 + 8 * h2);
        f32x16 o[4];
#pragma unroll
        for (int d0 = 0; d0 < 4; ++d0)
#pragma unroll
            for (int r = 0; r < 16; ++r) o[d0][r] = 0.f;
        float m = -1e30f, l = 0.f;
        asm volatile("s_waitcnt vmcnt(0)" ::: "memory");
#pragma unroll
        for (int d0 = 0; d0 < 8; ++d0) asm volatile("" : "+v"(qr[d0]));
        asm volatile("" : "+v"(m));
        attn_loop<128, 128, 128, PolC>(lds, P, qr, o, m, l, tid);
        store_ot<4>(o, 1.0f / l, O + (size_t)row * DM + P.h * 128, h2);
    }
}

struct PolD {
    static constexpr float sc2 = 0.125f * LOG2E;
    int nchunks, kcol; const bf16* QKV; const bf16* CK; const bf16* CV; int b, kvh, latent;
    int nl, kc0, qpos;
    DI void src(int c, const bf16*& kp, const bf16*& vp, size_t& st) const {
        if (latent && c >= nl) { const size_t off = ((size_t)(b * 512 + 64 * (c - nl)) * 8 + kvh) * 64; kp = CK + off; vp = CV + off; st = 512; }
        else { const int row = latent ? NCTX + b * 1024 + 64 * (kc0 + c) : b * 256 + 64 * c; kp = QKV + (size_t)row * 3072 + 2048 + kvh * 64; vp = kp + 512; st = 3072; }
    }
    DI bool active(int) const { return true; }
    DI void fix(int c, int kt, f32x16& s) const {
        if (latent && c < nl) {
            int h2 = (threadIdx.x >> 5) & 1; asm volatile("" : "+v"(h2));
#pragma unroll
            for (int rr = 0; rr < 16; ++rr) { const int kpos = 64 * (kc0 + c) + 32 * kt + crow(rr, h2); const int d = qpos - kpos;
                s[rr] = (d <= 128 && d >= -128) ? s[rr] : -INFINITY; }
        }
    }
};
DI void phaseD(const Args& A, ldsp lds, int G, int bid, int tid) {
    const int lane = tid & 63, wave = tid >> 6, r32 = lane & 31, h2 = lane >> 5, g = wave >> 1, qsub = wave & 1;
    const bf16* QKV = (const bf16*)(A.ws + WS_QKV); bf16* O = (bf16*)(A.ws + WS_O);
    for (int u = bid; u < 1024; u += G) {
        PolD P; P.QKV = QKV; P.CK = (const bf16*)(A.ws + WS_CDK); P.CV = (const bf16*)(A.ws + WS_CDV); P.kcol = 0;
        int row;
        if (u < 512) { const int uu = (G == 256) ? ((((u >> 8) * 64 + (bid & 7) * 8 + (bid >> 5)) << 2) | ((bid >> 3) & 3)) : u;
            P.latent = 0; P.b = uu >> 5; P.kvh = (uu >> 2) & 7; P.nchunks = 4; P.nl = 0; P.kc0 = 0; P.qpos = 0; row = P.b * 256 + 64 * (uu & 3) + 32 * qsub + r32; }
        else { const int v0 = u - 512; const int v = (G == 256) ? ((((v0 >> 8) * 16 + (bid & 7) * 2 + (bid >> 7)) << 4) | ((bid >> 3) & 15)) : v0;
            P.latent = 1; P.b = v >> 7; P.kvh = (v >> 4) & 7; const int qb = v & 15;
            P.kc0 = qb - 2 < 0 ? 0 : qb - 2; const int kc1 = qb + 3 > 15 ? 15 : qb + 3; P.nl = kc1 - P.kc0 + 1; P.nchunks = P.nl + 8;
            P.qpos = 64 * qb + 32 * qsub + r32; row = NCTX + P.b * 1024 + P.qpos; }
        bf16x8 qr[4];
#pragma unroll
        for (int d0 = 0; d0 < 4; ++d0) qr[d0] = *(const bf16x8*)(QKV + (size_t)row * 3072 + P.kvh * 256 + g * 64 + 16 * d0 + 8 * h2);
        f32x16 o[2];
#pragma unroll
        for (int d0 = 0; d0 < 2; ++d0)
#pragma unroll
            for (int r = 0; r < 16; ++r) o[d0][r] = 0.f;
        float m = A.in[31][P.kvh * 4 + g] * LOG2E, l = 1.0f;
        asm volatile("s_waitcnt vmcnt(0)" ::: "memory");
#pragma unroll
        for (int d0 = 0; d0 < 4; ++d0) asm volatile("" : "+v"(qr[d0]));
        asm volatile("" : "+v"(m));
        attn_loop<64, 64, 64, PolD>(lds, P, qr, o, m, l, tid);
        store_ot<2>(o, 1.0f / l, O + (size_t)row * DM + P.kvh * 256 + g * 64, h2);
    }
}

DI float logsigmoid(float x) { return fminf(x, 0.f) - log1pf(expf(-fabsf(x))); }
DI void mlstm_scan(const float* gates, int rowbase, int h, int dir, float m0, int T, LAS float* At, LAS float* Mt, LAS float* Gt, int lane) {
    float cG = 0.f, cM = m0;
#pragma unroll 1
    for (int seg = 0; seg < T; seg += 256) {
        float gi[4], gf[4];
#pragma unroll
        for (int e = 0; e < 4; ++e) { const int p = seg + lane * 4 + e, t = dir ? T - 1 - p : p; const float* gr = gates + (size_t)(rowbase + t) * 32 + dir * 16 + h;
            gi[e] = gr[0]; gf[e] = logsigmoid(gr[8]); }
        float run = 0.f;
#pragma unroll
        for (int e = 0; e < 4; ++e) { run += gf[e]; gf[e] = run; }
        float pre = run;
#pragma unroll
        for (int o = 1; o < 64; o <<= 1) { const float v = __shfl_up(pre, o); if (lane >= o) pre += v; }
        const float tot = __shfl(pre, 63);
        pre = pre - run + cG;
        float mx = -INFINITY;
#pragma unroll
        for (int e = 0; e < 4; ++e) { gf[e] += pre; gi[e] -= gf[e]; mx = fmaxf(mx, gi[e]); }
        float pm = mx;
#pragma unroll
        for (int o = 1; o < 64; o <<= 1) { const float v = __shfl_up(pm, o); if (lane >= o) pm = fmaxf(pm, v); }
        const float allm = __shfl(pm, 63);
        float ex = __shfl_up(pm, 1); if (lane == 0) ex = -INFINITY;
        float rm = fmaxf(cM, ex);
#pragma unroll
        for (int e = 0; e < 4; ++e) { const int p = seg + lane * 4 + e, t = dir ? T - 1 - p : p; rm = fmaxf(rm, gi[e]); At[t] = gi[e]; Mt[t] = rm; Gt[t] = gf[e]; }
        cG += tot; cM = fmaxf(cM, allm);
    }
}

constexpr int B_PKB = 272, B_PVB = 576, B_KBYTES = 64 * B_PKB, B_VBYTES = 64 * B_PVB, B_BUF = B_KBYTES + B_VBYTES;
constexpr int BR_K = 16384, BR_V = 32768, BR_STG = BR_K + BR_V, BR_NS = 3;
constexpr int BL_ET = BR_NS * BR_STG;
constexpr int BL_RC = BL_ET + 8192;
constexpr int BL_AD = BL_RC + 128;
constexpr int BL_MG = BL_AD + 512;
constexpr int BL_SX = BL_MG + 1024;
static_assert(BL_SX + 2048 <= LDS_PHASE_BYTES, "phase B LDS map");

template <int EL> DI void mlstm_scan8(const float* gates, int rowbase, int h, int T, int qb, float m0, ldsp lds, int wave, int lane) {
    const int dir = wave >> 2, sg = wave & 3, SL = 64 * EL;
    LAS float* Et = (LAS float*)(lds + BL_ET) + dir * 1024; LAS float* Rc = (LAS float*)(lds + BL_RC) + dir * 16; LAS float* Ad = (LAS float*)(lds + BL_AD) + dir * 64;
    LAS float* MG = (LAS float*)(lds + BL_MG) + dir * 128; LAS float* sx = (LAS float*)(lds + BL_SX);
    float gi[EL], gf[EL], pmx[EL];
#pragma unroll
    for (int e = 0; e < EL; ++e) { const int p = sg * SL + lane * EL + e, t = dir ? T - 1 - p : p; const float* gr = gates + (size_t)(rowbase + t) * 32 + dir * 16 + h;
        gi[e] = gr[0]; gf[e] = logsigmoid(gr[8]); }
    float run = 0.f;
#pragma unroll
    for (int e = 0; e < EL; ++e) { run += gf[e]; gf[e] = run; }
    float pre = run;
#pragma unroll
    for (int o = 1; o < 64; o <<= 1) { const float v = __shfl_up(pre, o); if (lane >= o) pre += v; }
    const float tot = __shfl(pre, 63);
    pre -= run;
    float mx = -INFINITY;
#pragma unroll
    for (int e = 0; e < EL; ++e) { gf[e] += pre; gi[e] -= gf[e]; mx = fmaxf(mx, gi[e]); pmx[e] = mx; }
    float pm = mx;
#pragma unroll
    for (int o = 1; o < 64; o <<= 1) { const float v = __shfl_up(pm, o); if (lane >= o) pm = fmaxf(pm, v); }
    const float allm = __shfl(pm, 63);
    float ex = __shfl_up(pm, 1); if (lane == 0) ex = -INFINITY;
    if (lane == 0) { sx[wave * 2] = tot; sx[wave * 2 + 1] = allm; }
    __syncthreads();
    float cG = 0.f, cM = m0;
    for (int s2 = 0; s2 < sg; ++s2) { cM = fmaxf(cM, sx[(dir * 4 + s2) * 2 + 1] - cG); cG += sx[(dir * 4 + s2) * 2]; }
    float cm = mx;
#pragma unroll
    for (int o = 1; o < 64 / EL; o <<= 1) cm = fmaxf(cm, __shfl_xor(cm, o));
    cm -= cG;
    const int p0 = sg * SL + lane * EL, t0 = dir ? T - 1 - p0 : p0, ch = t0 >> 6;
    if ((lane & (64 / EL - 1)) == 0) Rc[ch] = cm;
#pragma unroll
    for (int e = 0; e < EL; ++e) { const int p = p0 + e, t = dir ? T - 1 - p : p;
        const float a = gi[e] - cG, Gv = gf[e] + cG, Mv = fmaxf(fmaxf(cM, ex - cG), pmx[e] - cG);
        Et[t] = ex2((a - cm) * LOG2E);
        if (ch == qb) { Ad[t & 63] = a; MG[(t & 63) * 2] = Mv; MG[(t & 63) * 2 + 1] = Gv; } }
}

DI void phaseB(const Args& A, ldsp lds, int G, int bid, int tid) {
    const int lane = tid & 63, wave = __builtin_amdgcn_readfirstlane(tid >> 6), r32 = lane & 31, h2 = lane >> 5, i16 = lane & 15, tq = i16 >> 2, tp = i16 & 3, blk = (lane >> 4) & 1;
    const int qsub = wave & 1, dvh = (wave >> 1) & 1, dir = wave >> 2;
    const bf16* QKV = (const bf16*)(A.ws + WS_QKV); bf16* O = (bf16*)(A.ws + WS_O); const float* gates = (const float*)(A.ws + WS_GATES);
    LAS float* At = (LAS float*)(lds + BL_ET); LAS float* Mt = At + 256; LAS float* Gt = Mt + 256;
    LAS float* sx = (LAS float*)(lds + BL_SX);
    LAS float* xb = (LAS float*)lds;
    const float scale = 0.08838834764831845f;
    const int kx = r32 & 15, krow = r32 * 256;
    const int vbase = (4 * h2 + tq) * 512 + 32 * blk + 8 * tp;
    for (int u = bid; u < 1024; u += G) {
        int latent, b, h, qb, T, rowbase;
        if (u < 512) { const int uu = (G == 256) ? ((((u >> 8) * 64 + (bid & 7) * 8 + (bid >> 5)) << 2) | ((bid >> 3) & 3)) : u;
            latent = 0; b = uu >> 5; h = (uu >> 2) & 7; qb = uu & 3; T = 256; rowbase = b * 256; }
        else { const int v0 = u - 512; const int v = (G == 256) ? ((((v0 >> 8) * 16 + (bid & 7) * 2 + (bid >> 7)) << 4) | ((bid >> 3) & 15)) : v0;
            latent = 1; b = v >> 7; h = (v >> 4) & 7; qb = v & 15; T = 1024; rowbase = NCTX + b * 1024; }
        const int nch = T / 64;
        { const float m0s = latent ? A.in[6][(b * 2 + dir) * 8 + h] : 0.f;
          if (latent) mlstm_scan8<4>(gates, rowbase, h, T, qb, m0s, lds, wave, lane); else mlstm_scan8<1>(gates, rowbase, h, T, qb, m0s, lds, wave, lane); }
        __syncthreads();
        const int t = 64 * qb + 32 * qsub + r32, row = rowbase + t;
        const float Mq = ((LAS float*)(lds + BL_MG))[dir * 128 + (32 * qsub + r32) * 2], Gq = ((LAS float*)(lds + BL_MG))[dir * 128 + (32 * qsub + r32) * 2 + 1];
        const LAS float* Et = (const LAS float*)(lds + BL_ET) + dir * 1024; const LAS float* Rc = (const LAS float*)(lds + BL_RC) + dir * 16; const LAS float* Ad = (const LAS float*)(lds + BL_AD) + dir * 64;
        bf16x8 qr[8];
#pragma unroll
        for (int d0 = 0; d0 < 8; ++d0) qr[d0] = *(const bf16x8*)(QKV + (size_t)row * 6144 + h * 128 + 16 * d0 + 8 * h2);
        f32x16 o[4];
#pragma unroll
        for (int d0 = 0; d0 < 4; ++d0)
#pragma unroll
            for (int r = 0; r < 16; ++r) o[d0][r] = 0.f;
        float den = 0.f;
        const bf16* kp0 = QKV + (size_t)rowbase * 6144 + 1024 + h * 128; const bf16* vp0 = QKV + (size_t)rowbase * 6144 + 2048 + h * 256;
        asm volatile("s_waitcnt vmcnt(0) lgkmcnt(0)" ::: "memory");
#pragma unroll
        for (int d0 = 0; d0 < 8; ++d0) asm volatile("" : "+v"(qr[d0]));
#ifdef DUP_BLOOP
        for (int rep = 0; rep < 2; ++rep) {
#pragma unroll
        for (int d0 = 0; d0 < 4; ++d0)
#pragma unroll
            for (int r = 0; r < 16; ++r) o[d0][r] = 0.f;
        den = 0.f;
#endif
#pragma unroll
        for (int k = 0; k < 2; ++k) { ldsp sb = lds + k * BR_STG; dma_tile<256, false>(sb, kp0 + (size_t)(64 * k) * 6144, 6144, wave, lane); dma_tile<512, true>(sb + BR_K, vp0 + (size_t)(64 * k) * 6144, 6144, wave, lane); }
        for (int c = 0; c < nch; ++c) {
            if (c + 1 < nch) VM_WAIT_N(6); else VM_WAIT_N(0);
            __builtin_amdgcn_s_barrier(); asm volatile("" ::: "memory");
            if (c + 2 < nch) { const int stg = (c + 2) % BR_NS; ldsp sb = lds + stg * BR_STG; dma_tile<256, false>(sb, kp0 + (size_t)(64 * (c + 2)) * 6144, 6144, wave, lane); dma_tile<512, true>(sb + BR_K, vp0 + (size_t)(64 * (c + 2)) * 6144, 6144, wave, lane); }
            ldsp kb = lds + (c % BR_NS) * BR_STG; ldsp vb = kb + BR_K;
            const bool act = dir ? (c >= qb) : (c <= qb);
            if (act) {
                const bool diag = (c == qb);
                const float fc = ex2((Rc[c] - Mq) * LOG2E) * scale;
#pragma unroll
                for (int kt = 0; kt < 2; ++kt) {
                    const bool tact = !(diag && (dir ? kt < qsub : kt > qsub));
                    if (tact) {
                        f32x16 s;
#pragma unroll
                        for (int i = 0; i < 16; ++i) s[i] = 0.f;
#pragma unroll
                        for (int d0 = 0; d0 < 8; ++d0) { const bf16x8 a = *(const LAS bf16x8*)(kb + 32 * kt * 256 + krow + (((h2 + 2 * d0) ^ kx) << 4)); s = MFMA32(a, qr[d0], s); }
                        int h2l = h2; asm volatile("" : "+v"(h2l));
                        if (!diag) {
#pragma unroll
                            for (int g = 0; g < 4; ++g) { const f32x4 e4 = *(const LAS f32x4*)(Et + 64 * c + 32 * kt + 8 * g + 4 * h2l);
#pragma unroll
                                for (int j = 0; j < 4; ++j) { const float p = s[4 * g + j] * (e4[j] * fc); s[4 * g + j] = p; den += p; } }
                        } else {
#pragma unroll
                            for (int g = 0; g < 4; ++g) { const f32x4 a4 = *(const LAS f32x4*)(Ad + 32 * kt + 8 * g + 4 * h2l);
#pragma unroll
                                for (int j = 0; j < 4; ++j) { const int si = 64 * c + 32 * kt + 8 * g + 4 * h2l + j; const float w = ex2((a4[j] - Mq) * LOG2E);
                                    const bool ok = dir ? si >= t : si <= t; const float p = ok ? s[4 * g + j] * scale * w : 0.f; s[4 * g + j] = p; den += p; } }
                        }
                        const bf16x8 p0 = pack8<0>(s), p1 = pack8<1>(s);
                        const unsigned va0 = (unsigned)(__UINTPTR_TYPE__)vb + (unsigned)((32 * kt) * 512 + vbase);
#pragma unroll
                        for (int dp = 0; dp < 2; ++dp) {
                            const unsigned a = va0 + 64 * ((4 * dvh + 2 * dp) ^ tq), bq = va0 + 64 * ((4 * dvh + 2 * dp + 1) ^ tq);
                            const s16x4 l0 = tr_asm<0>(a), h0 = tr_asm<8 * 512>(a), l1 = tr_asm<16 * 512>(a), h1 = tr_asm<24 * 512>(a);
                            const s16x4 m0 = tr_asm<0>(bq), n0 = tr_asm<8 * 512>(bq), m1 = tr_asm<16 * 512>(bq), n1 = tr_asm<24 * 512>(bq);
                            asm volatile("s_waitcnt lgkmcnt(0)" ::: "memory"); __builtin_amdgcn_sched_barrier(0);
                            const bf16x8 a0 = {l0[0], l0[1], l0[2], l0[3], h0[0], h0[1], h0[2], h0[3]};
                            const bf16x8 a1 = {l1[0], l1[1], l1[2], l1[3], h1[0], h1[1], h1[2], h1[3]};
                            const bf16x8 b0 = {m0[0], m0[1], m0[2], m0[3], n0[0], n0[1], n0[2], n0[3]};
                            const bf16x8 b1 = {m1[0], m1[1], m1[2], m1[3], n1[0], n1[1], n1[2], n1[3]};
                            o[2 * dp] = MFMA32(a0, p0, o[2 * dp]);
                            o[2 * dp + 1] = MFMA32(b0, p0, o[2 * dp + 1]);
                            o[2 * dp] = MFMA32(a1, p1, o[2 * dp]);
                            o[2 * dp + 1] = MFMA32(b1, p1, o[2 * dp + 1]);
                        }
                    }
                }
            }
        }
        asm volatile("s_waitcnt lgkmcnt(0)" ::: "memory"); __builtin_amdgcn_s_barrier(); asm volatile("" ::: "memory");
#ifdef DUP_BLOOP
        }
#endif
        den = hsum(den);
#ifndef NO_BSTATE
        if (latent) {
            const float m0 = A.in[6][(b * 2 + dir) * 8 + h];
            const float coef = ex2((m0 - Mq) * LOG2E) * scale;
            const bf16* SC = (const bf16*)(A.ws + WS_SC) + ((size_t)((b * 2 + dir) * 8 + h) * 256 + dvh * 128 + r32) * 128 + 8 * h2;
#pragma unroll
            for (int d0 = 0; d0 < 4; ++d0) { f32x16 tmp;
#pragma unroll
                for (int r = 0; r < 16; ++r) tmp[r] = 0.f;
#pragma unroll
                for (int ds = 0; ds < 8; ++ds) { const bf16x8 a = *(const bf16x8*)(SC + (size_t)d0 * 32 * 128 + 16 * ds); tmp = MFMA32(a, qr[ds], tmp); }
#pragma unroll
                for (int r = 0; r < 16; ++r) o[d0][r] += coef * tmp[r]; }
            const float* n0 = A.in[5] + ((b * 2 + dir) * 8 + h) * 128 + 8 * h2;
            float dot = 0.f;
#pragma unroll
            for (int ds = 0; ds < 8; ++ds)
#pragma unroll
                for (int jj = 0; jj < 8; ++jj) dot += bf2f((unsigned short)qr[ds][jj]) * n0[16 * ds + jj];
            dot = hsum(dot);
            den += coef * dot;
        }
#endif
        const float hinv = 1.0f / fmaxf(fabsf(den), __expf(-(Gq + Mq)));
        if (dir == 1) {
#pragma unroll
            for (int d0 = 0; d0 < 4; ++d0)
#pragma unroll
                for (int r = 0; r < 16; ++r) xb[(((wave & 3) * 4 + d0) * 16 + r) * 64 + lane] = o[d0][r] * hinv;
        }
        __syncthreads();
        float ss = 0.f;
        if (dir == 0) {
#pragma unroll
            for (int d0 = 0; d0 < 4; ++d0)
#pragma unroll
                for (int r = 0; r < 16; ++r) { const float v = o[d0][r] * hinv + xb[((wave * 4 + d0) * 16 + r) * 64 + lane]; o[d0][r] = v; ss += v * v; }
            ss = hsum(ss);
            if (h2 == 0) sx[wave * 32 + r32] = ss;
        }
        __syncthreads();
        if (dir == 0) {
            const float tot = ss + sx[(wave ^ 2) * 32 + r32];
            const float rs = 1.0f / sqrtf(tot * (1.f / 256.f) + RMS_EPS);
            const float* nw = A.in[25] + h * 256 + dvh * 128; const bf16* og = QKV + (size_t)row * 6144 + 4096 + h * 256 + dvh * 128;
#pragma unroll
            for (int d0 = 0; d0 < 4; ++d0)
#pragma unroll
                for (int g = 0; g < 4; ++g) { const int dv = 32 * d0 + 8 * g + 4 * h2;
                    const u32x2 ow = *(const u32x2*)(og + dv); const f32x4 nv = *(const f32x4*)(nw + dv);
                    const float g0 = 1.f / (1.f + __expf(-bflo(ow.x))), g1 = 1.f / (1.f + __expf(-bfhi(ow.x))), g2 = 1.f / (1.f + __expf(-bflo(ow.y))), g3 = 1.f / (1.f + __expf(-bfhi(ow.y)));
                    u32x2 w; w.x = pk2(o[d0][4 * g] * rs * nv[0] * g0, o[d0][4 * g + 1] * rs * nv[1] * g1); w.y = pk2(o[d0][4 * g + 2] * rs * nv[2] * g2, o[d0][4 * g + 3] * rs * nv[3] * g3);
                    *(u32x2*)(O + (size_t)row * DM + h * 256 + dvh * 128 + dv) = w; }
        }
        __syncthreads();
    }
    LAS float* Wt = sx + 256;
#ifndef NO_BFINAL
    for (int u = bid; u < 256; u += G) {
        const int b = u >> 4, h = (u >> 1) & 7, sd = u & 1, rowbase = b * 256;
        if (wave == 0) mlstm_scan(gates, rowbase, h, sd, 0.f, 256, At, Mt, Gt, lane);
        __syncthreads();
        const int tl = sd ? 0 : 255;
        const float MT = Mt[tl], GT = Gt[tl];
        if (tid < 256) Wt[tid] = ex2((At[tid] - MT) * LOG2E);
        __syncthreads();
        f32x16 acc[4];
#pragma unroll
        for (int nt = 0; nt < 4; ++nt)
#pragma unroll
            for (int r = 0; r < 16; ++r) acc[nt][r] = 0.f;
        float nacc = 0.f;
        const int aoff = (8 * h2 + tq) * B_PVB + (32 * wave + 16 * blk + 4 * tp) * 2;
        const int boff = (8 * h2 + tq) * B_PKB + (16 * blk + 4 * tp) * 2;
        bf16x8 kst[2], vst[4];
        { const bf16* kp = QKV + (size_t)rowbase * 6144 + 1024 + h * 128; const bf16* vp = QKV + (size_t)rowbase * 6144 + 2048 + h * 256;
          stage_ld<128>(kst, kp, 6144, tid); stage_ld<256>(vst, vp, 6144, tid); }
        for (int c = 0; c < 4; ++c) {
            ldsp kb = lds + (c & 1) * B_BUF; ldsp vb = kb + B_KBYTES;
#pragma unroll
            for (int i = 0; i < 4; ++i) { const int idx = tid + NTHR * i, rw = idx / 32; const float w = Wt[64 * c + rw];
                const u32x4 x = __builtin_bit_cast(u32x4, vst[i]); u32x4 y;
                y.x = pk2(bflo(x.x) * w, bfhi(x.x) * w); y.y = pk2(bflo(x.y) * w, bfhi(x.y) * w); y.z = pk2(bflo(x.z) * w, bfhi(x.z) * w); y.w = pk2(bflo(x.w) * w, bfhi(x.w) * w);
                vst[i] = __builtin_bit_cast(bf16x8, y); }
            stage_st<128>(kst, kb, B_PKB, tid); stage_st<256>(vst, vb, B_PVB, tid);
            __syncthreads();
            if (c + 1 < 4) { const bf16* kp = QKV + (size_t)(rowbase + 64 * (c + 1)) * 6144 + 1024 + h * 128; const bf16* vp = QKV + (size_t)(rowbase + 64 * (c + 1)) * 6144 + 2048 + h * 256;
                stage_ld<128>(kst, kp, 6144, tid); stage_ld<256>(vst, vp, 6144, tid); }
#pragma unroll
            for (int ks = 0; ks < 4; ++ks) {
                const s16x4 al = tr_read(vb + aoff + 16 * ks * B_PVB), ah = tr_read(vb + aoff + (16 * ks + 4) * B_PVB);
                const bf16x8 a = {al[0], al[1], al[2], al[3], ah[0], ah[1], ah[2], ah[3]};
#pragma unroll
                for (int nt = 0; nt < 4; ++nt) {
                    const s16x4 bl = tr_read(kb + boff + 16 * ks * B_PKB + 64 * nt), bh = tr_read(kb + boff + (16 * ks + 4) * B_PKB + 64 * nt);
                    const bf16x8 bb = {bl[0], bl[1], bl[2], bl[3], bh[0], bh[1], bh[2], bh[3]};
                    acc[nt] = MFMA32(a, bb, acc[nt]);
                }
            }
            if (tid < 128) {
#pragma unroll 8
                for (int s = 0; s < 64; ++s) nacc += Wt[64 * c + s] * bf2f(*(const LAS unsigned short*)(kb + s * B_PKB + tid * 2));
            }
        }
        float* oc = A.out + O_BC + ((size_t)((b * 2 + sd) * 8 + h) * 256) * 128;
#pragma unroll
        for (int nt = 0; nt < 4; ++nt)
#pragma unroll
            for (int r = 0; r < 16; ++r) oc[(size_t)(32 * wave + crow(r, h2)) * 128 + 32 * nt + r32] = acc[nt][r];
        if (tid < 128) A.out[O_BN + ((b * 2 + sd) * 8 + h) * 128 + tid] = nacc;
        if (tid == 0) A.out[O_BM + (b * 2 + sd) * 8 + h] = GT + MT;
        __syncthreads();
    }
#endif
}

constexpr int N_PHASES = 3 + 7 * NLAYER;
#define PH(b) ((MASK >> (b)) & 1)
#ifndef DUPMASK
#define DUPMASK 0
#endif
#define DUP(b) (((DUPMASK >> (b)) & 1) ? 2 : 1)
template <int MASK> __global__ void __launch_bounds__(NTHR, 2) fwd_kernel(Args args) {
    extern __shared__ __attribute__((aligned(16))) unsigned char lds_raw[];
    ldsp lds = (ldsp)lds_raw;
    const int tid0 = threadIdx.x, bid = blockIdx.x, G = gridDim.x;
#define TIDL() ({ int t_ = threadIdx.x; asm volatile("" : "+v"(t_)); t_; })
    const int tid = tid0;
    volatile LAS unsigned* MISC = (volatile LAS unsigned*)(lds + MISC_OFF);
    for (int u = tid; u < 64; u += NTHR) MISC[u] = 0u;
    __syncthreads();
    const int lo = args.ph_lo, hi = args.ph_hi;
    unsigned* ctl = (unsigned*)(args.ws + WS_CTL);
    XcdBarrier bar; bar.bar = ctl + CW_BAR; bar.x = 0; bar.st = nullptr;
    const bool multi = (hi - lo) > 1;
    if (multi) bar = xcd_barrier_post(ctl + CW_BAR, MISC + 8);
#define IN(k) (lo <= (k) && (k) < hi)
#define SEAM(k) do { if (IN(k) && IN((k) + 1)) xcd_barrier(bar); } while (0)
    unsigned char* ws = args.ws;
    bf16* Hb = (bf16*)(ws + WS_H); bf16* QKVb = (bf16*)(ws + WS_QKV); bf16* Ob = (bf16*)(ws + WS_O); bf16* Yb = (bf16*)(ws + WS_Y); bf16* Ub = (bf16*)(ws + WS_U);

    if (DUP(12) == 2 && multi) { for (int rep = 0; rep < 32; ++rep) xcd_barrier(bar); }
    if (PH(0) && IN(0)) { for (int rep = 0; rep < DUP(0); ++rep) { p0a_prologue(args, lds, G, bid, TIDL()); __syncthreads(); } } SEAM(0);
    if (PH(1) && IN(1)) { p0b_modreduce(args, G, bid, TIDL()); } SEAM(1);
    if (PH(2) && IN(2)) { RowP P; P.Y = nullptr; P.mod_gate = 0; P.Lg = 0; P.gpost = 0; P.has_next = 1; P.Ln = 0; P.gpre = 0; P.mod_shift = 0; P.do_gates = 0; P.dry = 0; row_phase(args, P, lds, G, bid, TIDL()); } SEAM(2);

    for (int L = 0; L < NLAYER; ++L) {
        const int base = 3 + 7 * L;
        if (PH(3) && IN(base)) {
            pg8::EpiInProj E; E.O = QKVb; E.rtab = (const float*)(ws + WS_ROPE);
            const bf16* Wt; int N;
            if (L == 0)      { Wt = (const bf16*)(ws + W_AIN); N = 6144; E.ck = args.out + O_AK; E.cv = args.out + O_AV; E.kc0 = 2048; E.vc0 = 4096; E.kw = 2048; E.rope_cols = 4096; }
            else if (L == 1) { Wt = (const bf16*)(ws + W_BIN); N = 6144; E.ck = nullptr; E.cv = nullptr; E.kc0 = 0; E.vc0 = 0; E.kw = 0; E.rope_cols = 0; }
            else if (L == 2) { Wt = (const bf16*)(ws + W_CIN); N = 6144; E.ck = args.out + O_CK; E.cv = args.out + O_CV; E.kc0 = 2048; E.vc0 = 4096; E.kw = 2048; E.rope_cols = 0; }
            else             { Wt = (const bf16*)(ws + W_DIN); N = 3072; E.ck = args.out + O_DK; E.cv = args.out + O_DV; E.kc0 = 2048; E.vc0 = 2560; E.kw = 512; E.rope_cols = 2560; }
            E.ldc = N;
            pg8::Gemm g{Hb, Wt, NTOK, N, DM}; pg8::StaticOrder S; S.init(NTOK, N, G, bid);
            for (int rep = 0; rep < DUP(3); ++rep) { pg8::gemm_phase<pg8::EpiInProj, pg8::StaticOrder, false, true>((LAS unsigned char*)lds, g, S, E); __syncthreads(); }
        }
        SEAM(base);
        if (IN(base + 1)) { for (int rep = 0; rep < DUP(4 + L); ++rep) {
            if (PH(4) && L == 0) phaseA(args, lds, G, bid, TIDL());
            if (PH(5) && L == 1) phaseB(args, lds, G, bid, TIDL());
            if (PH(6) && L == 2) phaseC(args, lds, G, bid, TIDL());
            if (PH(7) && L == 3) phaseD(args, lds, G, bid, TIDL());
        } }
        SEAM(base + 1);
        if (PH(8) && IN(base + 2)) {
            const size_t wo = L == 0 ? W_AOUT : (L == 1 ? W_BOUT : (L == 2 ? W_COUT : W_DOUT));
            pg8::Gemm g{Ob, (const bf16*)(ws + wo), NTOK, DM, DM}; pg8::StaticOrder S; S.init(NTOK, DM, G, bid);
            pg8::EpiBf16<false> E{Yb, DM};
            for (int rep = 0; rep < DUP(8); ++rep) { pg8::gemm_phase<pg8::EpiBf16<false>, pg8::StaticOrder, true, true>((LAS unsigned char*)lds, g, S, E); __syncthreads(); }
        }
        SEAM(base + 2);
        if (PH(2) && IN(base + 3)) { RowP P; P.Y = Yb; P.mod_gate = 2; P.Lg = L; P.gpost = L * 4 + 1; P.has_next = 1; P.Ln = L; P.gpre = L * 4 + 2; P.mod_shift = 3; P.do_gates = 0; P.dry = 1; if (DUP(2) == 2) { row_phase(args, P, lds, G, bid, TIDL()); __syncthreads(); } P.dry = 0; row_phase(args, P, lds, G, bid, TIDL()); }
        SEAM(base + 3);
        if (PH(9) && IN(base + 4)) {
            pg8::Gemm g{Hb, (const bf16*)(ws + W_FF1) + (size_t)L * DM * DFF, NTOK, DFF, DM}; pg8::StaticOrder S; S.init(NTOK, DFF, G, bid);
            pg8::EpiBf16<true> E{Ub, DFF};
            for (int rep = 0; rep < DUP(9); ++rep) { pg8::gemm_phase<pg8::EpiBf16<true>, pg8::StaticOrder, false, true>((LAS unsigned char*)lds, g, S, E); __syncthreads(); }
        }
        SEAM(base + 4);
        if (PH(10) && IN(base + 5)) {
            pg8::Gemm g{Ub, (const bf16*)(ws + W_FF2) + (size_t)L * DM * DFF, NTOK, DM, DFF}; pg8::StaticOrder S; S.init(NTOK, DM, G, bid);
            pg8::EpiBf16<false> E{Yb, DM};
            for (int rep = 0; rep < DUP(10); ++rep) { pg8::gemm_phase<pg8::EpiBf16<false>, pg8::StaticOrder, true, true>((LAS unsigned char*)lds, g, S, E); __syncthreads(); }
        }
        SEAM(base + 5);
        if (PH(2) && IN(base + 6)) { RowP P; P.Y = Yb; P.mod_gate = 5; P.Lg = L; P.gpost = L * 4 + 3; P.has_next = (L + 1 < NLAYER); P.Ln = L + 1; P.gpre = (L + 1) * 4; P.mod_shift = 0; P.do_gates = (L + 1 == 1); P.dry = 1; if (DUP(2) == 2) { row_phase(args, P, lds, G, bid, TIDL()); __syncthreads(); } P.dry = 0; row_phase(args, P, lds, G, bid, TIDL()); }
        SEAM(base + 6);
    }
#undef IN
#undef SEAM
}

#ifndef FULLMASK
#define FULLMASK 0xFFFF
#endif
#ifndef MK_PER_PHASE
#define MK_PER_PHASE 0
#endif
template <int MASK> static int setup_kernel() {
    if (hipFuncSetAttribute((const void*)fwd_kernel<MASK>, hipFuncAttributeMaxDynamicSharedMemorySize, LDS_BYTES) != hipSuccess) { fprintf(stderr, "kernel_launch: hipFuncSetAttribute failed (mask %x)\n", MASK); return -1; }
    return 0;
}
template <int MASK> static void launch_range(const Args& a, int grid, hipStream_t stream) { hipLaunchKernelGGL(fwd_kernel<MASK>, dim3(grid), dim3(NTHR), LDS_BYTES, stream, a); }
extern "C" void kernel_launch(void* const* d_in, const int* in_sizes, int n_in, void* d_out, int out_size, void* d_ws, size_t ws_size, hipStream_t stream) {
    static int grid = 0;
    if (grid == 0) {
        if (n_in != 32 || out_size != (int)O_END || ws_size < WS_END) { fprintf(stderr, "kernel_launch: unexpected shapes: n_in %d out %d ws %zu (need %zu)\n", n_in, out_size, ws_size, (size_t)WS_END); grid = -1; return; }
        int dev = 0, cus = 0;
        if (hipGetDevice(&dev) != hipSuccess || hipDeviceGetAttribute(&cus, hipDeviceAttributeMultiprocessorCount, dev) != hipSuccess) { grid = -1; return; }
#if MK_PER_PHASE
        if (setup_kernel<1>() || setup_kernel<2>() || setup_kernel<4>() || setup_kernel<8>() || setup_kernel<16>() || setup_kernel<32>() || setup_kernel<64>() || setup_kernel<128>() || setup_kernel<256>() || setup_kernel<512>() || setup_kernel<1024>()) { grid = -1; return; }
#else
        if (setup_kernel<FULLMASK>()) { grid = -1; return; }
#endif
        (void)hipGetLastError();
        grid = cus;
    }
    if (grid < 0) return;
    (void)hipMemsetAsync((char*)d_ws + WS_CTL, 0, CTL_ZERO_BYTES, stream);
    Args a{};
    for (int i = 0; i < 32; ++i) a.in[i] = (const float*)d_in[i];
    a.out = (float*)d_out; a.ws = (unsigned char*)d_ws;
#if MK_PER_PHASE
    for (int p = 0; p < N_PHASES; ++p) {
        a.ph_lo = p; a.ph_hi = p + 1;
        if (p == 0) launch_range<1>(a, grid, stream);
        else if (p == 1) launch_range<2>(a, grid, stream);
        else if (p == 2) launch_range<4>(a, grid, stream);
        else { const int L = (p - 3) / 7, k = (p - 3) % 7;
            if (k == 0) launch_range<8>(a, grid, stream);
            else if (k == 1) { if (L == 0) launch_range<16>(a, grid, stream); else if (L == 1) launch_range<32>(a, grid, stream); else if (L == 2) launch_range<64>(a, grid, stream); else launch_range<128>(a, grid, stream); }
            else if (k == 2) launch_range<256>(a, grid, stream);
            else if (k == 3 || k == 6) launch_range<4>(a, grid, stream);
            else if (k == 4) launch_range<512>(a, grid, stream);
            else launch_range<1024>(a, grid, stream);
        }
    }
#else
    a.ph_lo = 0; a.ph_hi = N_PHASES; launch_range<FULLMASK>(a, grid, stream);
#endif
    const hipError_t le = hipPeekAtLastError();
    if (le != hipSuccess) fprintf(stderr, "kernel_launch: launch failed: %s\n", hipGetErrorName(le));
}
```

```cpp
#include <hip/hip_runtime.h>
#include <cstdio>
#include <cstdint>
#include <cmath>
namespace pg8 {
#define PG8_LAS __attribute__((address_space(3)))
typedef unsigned short bf16_t;
typedef short bf16x8 __attribute__((ext_vector_type(8)));
typedef float f32x4 __attribute__((ext_vector_type(4)));
typedef unsigned u32x4 __attribute__((ext_vector_type(4)));
constexpr int BM = 256, BK = 64, HALF = 128, HTB = HALF * BK * 2  , STAGE_BYTES = 8 * HTB, NXCD = 8, WGM = 4;

__host__ __device__ __forceinline__ int lds_byte(int r, int c) { const int st = (r >> 4) * 2 + (c >> 5), rr = r & 15, cc = c & 31, ob = rr * 64 + cc * 2; return st * 1024 + (ob ^ (((ob >> 9) & 1) << 5)); }
__host__ __device__ __forceinline__ void stage_rc(int b, int& R, int& C) { const int st = b / 1024, sb = b % 1024, swz = sb ^ (((sb >> 9) & 1) << 5); R = (st >> 1) * 16 + swz / 64; C = (st & 1) * 32 + (swz % 64) / 2; }
__host__ __device__ __forceinline__ int perm32(int rho) { const int n = rho >> 4, i = rho & 15; return 8 * (i >> 2) + 4 * n + (i & 3); }

struct Unit { int pm, pn; };
struct Gemm { const bf16_t* A; const bf16_t* Bt; int M, N, K; };

struct StaticOrder {
    int nM, nN, nwg, G, c;
    __host__ __device__ void init(int M, int N, int G_, int c_) { nM = M / BM; nN = N / BM; nwg = nM * nN; G = G_; c = c_; }
    __host__ __device__ bool next(int i, Unit& u) const {
        const long L = (long)i * G + c; if (L >= nwg) return false;
        int wgid = (int)L; { const int q = nwg / NXCD, r = nwg % NXCD, xcd = wgid % NXCD, off = wgid / NXCD; wgid = (xcd < r ? xcd * (q + 1) : r * (q + 1) + (xcd - r) * q) + off; }
        const int nig = WGM * nN, gid = wgid / nig, fm = gid * WGM, gsz = (nM - fm) < WGM ? (nM - fm) : WGM;
        u.pm = fm + ((wgid % nig) % gsz); u.pn = (wgid % nig) / gsz; return true;
    }
    __device__ __forceinline__ void a_ready(const Unit&) const {}
    __device__ __forceinline__ void done(const Unit&) const {}
};

__device__ __forceinline__ unsigned cvt_pk_bf16(float lo, float hi) { unsigned r; asm volatile("v_cvt_pk_bf16_f32 %0, %1, %2" : "=v"(r) : "v"(lo), "v"(hi)); return r; }
typedef float f32x2 __attribute__((ext_vector_type(2)));

struct EpiF32 {
    static constexpr bool PERM = false, AFTER_DRAIN = false;
    float* C; int ldc;
    __device__ __forceinline__ void operator()(const f32x4 (&acc)[2][2][4][2], const Unit& u, int wr, int wc, int fr, int fq) const {
        const int row0 = u.pm * BM + wr * 64 + fr, col0 = u.pn * BM + wc * 32 + 4 * fq;
#pragma unroll
        for (int ai = 0; ai < 2; ++ai)
#pragma unroll
            for (int m = 0; m < 4; ++m) { float* rowp = C + (size_t)(row0 + ai * HALF + m * 16) * ldc + col0;
#pragma unroll
                for (int bj = 0; bj < 2; ++bj)
#pragma unroll
                    for (int n = 0; n < 2; ++n) *(f32x4*)(rowp + bj * HALF + n * 16) = acc[ai][bj][m][n]; }
    }
};
template <bool ACT> struct EpiBf16 {
    static constexpr bool PERM = true, AFTER_DRAIN = false;
    bf16_t* O; int ldc;
    __device__ __forceinline__ void operator()(const f32x4 (&acc)[2][2][4][2], const Unit& u, int wr, int wc, int fr, int fq) const {
        const int row0 = u.pm * BM + wr * 64 + fr, col0 = u.pn * BM + wc * 32 + 8 * fq;
#pragma unroll
        for (int ai = 0; ai < 2; ++ai)
#pragma unroll
            for (int m = 0; m < 4; ++m) { bf16_t* rowp = O + (size_t)(row0 + ai * HALF + m * 16) * ldc + col0;
#pragma unroll
                for (int bj = 0; bj < 2; ++bj) { f32x4 v0 = acc[ai][bj][m][0], v1 = acc[ai][bj][m][1];
#pragma unroll
                    for (int e = 0; e < 4; ++e) { if (ACT) { const float a = fmaxf(v0[e], 0.f), b = fmaxf(v1[e], 0.f); v0[e] = a * a; v1[e] = b * b; } }
                    u32x4 w; w.x = cvt_pk_bf16(v0[0], v0[1]); w.y = cvt_pk_bf16(v0[2], v0[3]); w.z = cvt_pk_bf16(v1[0], v1[1]); w.w = cvt_pk_bf16(v1[2], v1[3]);
                    *(u32x4*)(rowp + bj * HALF) = w; } }
    }
};
struct EpiInProj {
    static constexpr bool PERM = true, AFTER_DRAIN = false;
    bf16_t* O; int ldc;
    float* ck; float* cv;
    int kc0, vc0, kw;
    int rope_cols;
    const PG8_LAS float* rtab;
    __device__ __forceinline__ void operator()(const f32x4 (&acc)[2][2][4][2], const Unit& u, int wr, int wc, int fr, int fq) const {
        const int row0 = u.pm * BM + wr * 64 + fr, colt = u.pn * BM, col0 = colt + wc * 32 + 8 * fq;
        float* cdst = nullptr; int ccol = 0;
        if (u.pm < 16 && ck != nullptr) {
            if (colt >= kc0 && colt < kc0 + kw) { cdst = ck; ccol = col0 - kc0; }
            else if (colt >= vc0 && colt < vc0 + kw) { cdst = cv; ccol = col0 - vc0; }
        }
        const bool rope = (u.pm >= 16) && (colt < rope_cols);
#pragma unroll
        for (int ai = 0; ai < 2; ++ai)
#pragma unroll
            for (int m = 0; m < 4; ++m) {
                const int row = row0 + ai * HALF + m * 16;
                bf16_t* rowp = O + (size_t)row * ldc + col0;
                int pos = 0; if (rope) { const int t = row & 1023; pos = (wc & 1) ? (t & 63) : (t >> 6); }
                const PG8_LAS f32x4* tb = (const PG8_LAS f32x4*)(rtab + (pos * 16 + 8 * (fq & 1)) * 2);
#pragma unroll
                for (int bj = 0; bj < 2; ++bj) { f32x4 v0 = acc[ai][bj][m][0], v1 = acc[ai][bj][m][1];
                    if (rope) {
                        const f32x4 t0 = tb[0], t1 = tb[1], t2 = tb[2], t3 = tb[3];
                        const float cs[8] = {t0[0], t0[2], t1[0], t1[2], t2[0], t2[2], t3[0], t3[2]};
                        const float sn[8] = {t0[1], t0[3], t1[1], t1[3], t2[1], t2[3], t3[1], t3[3]};
#pragma unroll
                        for (int e = 0; e < 4; ++e) {
                            const float a = v0[e], pa = __shfl_xor(a, 32), b = v1[e], pb = __shfl_xor(b, 32);
                            v0[e] = (fq < 2) ? a * cs[e] - pa * sn[e] : pa * sn[e] + a * cs[e];
                            v1[e] = (fq < 2) ? b * cs[4 + e] - pb * sn[4 + e] : pb * sn[4 + e] + b * cs[4 + e];
                        }
                    }
                    u32x4 w; w.x = cvt_pk_bf16(v0[0], v0[1]); w.y = cvt_pk_bf16(v0[2], v0[3]); w.z = cvt_pk_bf16(v1[0], v1[1]); w.w = cvt_pk_bf16(v1[2], v1[3]);
                    *(u32x4*)(rowp + bj * HALF) = w;
                    if (cdst) { float* cp = cdst + (size_t)row * kw + ccol + bj * HALF; *(f32x4*)cp = v0; *(f32x4*)(cp + 4) = v1; }
                } }
    }
};

template <class Epi, class Sched, bool ALIGN_EPI = false, bool SP2 = false>
__device__ __forceinline__ void gemm_phase(PG8_LAS unsigned char* lds, const Gemm g, const Sched& S, const Epi& E) {
    int tid_raw = threadIdx.x; asm volatile("" : "+v"(tid_raw));
    const int tid = tid_raw, wid = __builtin_amdgcn_readfirstlane(tid >> 6), lane = tid & 63, wr = wid >> 2, wc = wid & 3, fr = lane & 15, fq = lane >> 4;
    const int K = g.K, nt = K / BK;
    unsigned voffA[2], voffB[2];
#pragma unroll
    for (int i = 0; i < 2; ++i) { int R, C; stage_rc(tid * 16 + i * 8192, R, C); const int Rb = Epi::PERM ? ((R & ~31) + perm32(R & 31)) : R;
        voffA[i] = (unsigned)(R * K + C) * 2u; voffB[i] = (unsigned)(Rb * K + C) * 2u; }
    const size_t kstep = (size_t)(BK * 2);
    const size_t hstep = (size_t)HALF * K * 2;
    const size_t tstep = 2 * hstep;
    const unsigned ldsw = (unsigned)wid * 1024u;
    const int aoff = lds_byte(wr * 64 + fr, fq * 8), boff = lds_byte(wc * 32 + fr, fq * 8);
#define PG8_SA(b, h) (((b) * 2 + (h)) * HTB)
#define PG8_SB(b, h) ((4 + (b) * 2 + (h)) * HTB)
#define PG8_STAGE(bufoff, gbase, voff) do { _Pragma("unroll") for (int _i = 0; _i < 2; ++_i) \
        __builtin_amdgcn_global_load_lds((const unsigned*)((const char*)(gbase) + (voff)[_i]), (PG8_LAS unsigned*)(lds + (bufoff) + ldsw + _i * 8192), 16, 0, 0); } while (0)
#define PG8_LDA(dst, b, h) do { _Pragma("unroll") for (int m = 0; m < 4; ++m) _Pragma("unroll") for (int k = 0; k < 2; ++k) dst[m][k] = *(const PG8_LAS bf16x8*)(lds + PG8_SA(b, h) + aoff + m * 2048 + k * 1024); } while (0)
#define PG8_LDB(dst, b, h) do { _Pragma("unroll") for (int n = 0; n < 2; ++n) _Pragma("unroll") for (int k = 0; k < 2; ++k) dst[n][k] = *(const PG8_LAS bf16x8*)(lds + PG8_SB(b, h) + boff + n * 2048 + k * 1024); } while (0)
#define PG8_MMA(ai, bj, At, Bt) do { __builtin_amdgcn_s_setprio(1); _Pragma("unroll") for (int m = 0; m < 4; ++m) _Pragma("unroll") for (int n = 0; n < 2; ++n) _Pragma("unroll") for (int k = 0; k < 2; ++k) \
        acc[ai][bj][m][n] = __builtin_amdgcn_mfma_f32_16x16x32_bf16(Bt[n][k], At[m][k], acc[ai][bj][m][n], 0, 0, 0); __builtin_amdgcn_s_setprio(0); } while (0)
#define PG8_WAIT_V(n) asm volatile("s_waitcnt vmcnt(" #n ")" ::: "memory")
#define PG8_WAIT_L(n) asm volatile("s_waitcnt lgkmcnt(" #n ")" ::: "memory")
#define PG8_BAR __builtin_amdgcn_s_barrier()
#define PG8_SCHED __builtin_amdgcn_sched_barrier(0)
    Unit cur, nxt; int ui = 0;
    if (!S.next(0, cur)) return;
    f32x4 acc[2][2][4][2];
#pragma unroll
    for (int a = 0; a < 2; ++a)
#pragma unroll
        for (int b = 0; b < 2; ++b)
#pragma unroll
            for (int m = 0; m < 4; ++m)
#pragma unroll
                for (int n = 0; n < 2; ++n) acc[a][b][m][n] = (f32x4){0.f, 0.f, 0.f, 0.f};
    bf16x8 At[4][2], B0[2][2], B1[2][2];
    const char* cA = (const char*)g.A + (size_t)cur.pm * tstep; const char* cB = (const char*)g.Bt + (size_t)cur.pn * tstep;
    S.a_ready(cur);
    if constexpr (SP2) {
        PG8_STAGE(PG8_SB(0, 0), cB, voffB); PG8_STAGE(PG8_SB(0, 1), cB + hstep, voffB); PG8_STAGE(PG8_SA(0, 0), cA, voffA); PG8_STAGE(PG8_SA(0, 1), cA + hstep, voffA);
        if (wr == 1) PG8_BAR;
        PG8_WAIT_V(2); PG8_BAR;
        PG8_STAGE(PG8_SB(1, 0), cB + kstep, voffB); PG8_STAGE(PG8_SA(1, 0), cA + kstep, voffA); PG8_STAGE(PG8_SB(1, 1), cB + hstep + kstep, voffB);
        PG8_WAIT_V(6); PG8_BAR;
    } else {
        PG8_STAGE(PG8_SB(0, 0), cB, voffB); PG8_STAGE(PG8_SA(0, 0), cA, voffA); PG8_STAGE(PG8_SB(0, 1), cB + hstep, voffB); PG8_STAGE(PG8_SA(0, 1), cA + hstep, voffA);
        if (wr == 1) PG8_BAR;
        PG8_WAIT_V(4); PG8_BAR;
        PG8_STAGE(PG8_SB(1, 0), cB + kstep, voffB); PG8_STAGE(PG8_SA(1, 0), cA + kstep, voffA); PG8_STAGE(PG8_SB(1, 1), cB + hstep + kstep, voffB);
        PG8_WAIT_V(6); PG8_BAR;
    }
    for (;;) {
        const bool has_next = S.next(ui + 1, nxt);
        const char* nA = has_next ? (const char*)g.A + (size_t)nxt.pm * tstep : cA; const char* nB = has_next ? (const char*)g.Bt + (size_t)nxt.pn * tstep : cB;
        for (int t = 0; t < nt; t += 2) {
            const bool last = (t == nt - 2);
            const char* a1 = cA + (size_t)(t + 1) * kstep;
            const char* a2 = last ? nA : cA + (size_t)(t + 2) * kstep; const char* b2 = last ? nB : cB + (size_t)(t + 2) * kstep;
            const char* a3 = a2 + kstep; const char* b3 = b2 + kstep;
            if (last && has_next) S.a_ready(nxt);
            if constexpr (SP2) {
            PG8_LDB(B0, 0, 0); PG8_LDB(B1, 0, 1); PG8_SCHED; PG8_LDA(At, 0, 0); PG8_STAGE(PG8_SA(1, 1), a1 + hstep, voffA);
            PG8_WAIT_V(8); PG8_WAIT_L(0); PG8_BAR; PG8_MMA(0, 0, At, B0); PG8_MMA(0, 1, At, B1); PG8_BAR; PG8_SCHED;
            PG8_LDA(At, 0, 1); PG8_STAGE(PG8_SB(0, 0), b2, voffB); PG8_STAGE(PG8_SB(0, 1), b2 + hstep, voffB); PG8_STAGE(PG8_SA(0, 0), a2, voffA);
            PG8_WAIT_V(8); PG8_WAIT_L(0); PG8_BAR; PG8_MMA(1, 0, At, B0); PG8_MMA(1, 1, At, B1); PG8_BAR; PG8_SCHED;
            PG8_LDB(B0, 1, 0); PG8_LDB(B1, 1, 1); PG8_SCHED; PG8_LDA(At, 1, 0); PG8_STAGE(PG8_SA(0, 1), a2 + hstep, voffA);
            PG8_WAIT_V(8); PG8_WAIT_L(0); PG8_BAR; PG8_MMA(0, 0, At, B0); PG8_MMA(0, 1, At, B1); PG8_BAR; PG8_SCHED;
            PG8_LDA(At, 1, 1); PG8_STAGE(PG8_SB(1, 0), b3, voffB); PG8_STAGE(PG8_SB(1, 1), b3 + hstep, voffB); PG8_STAGE(PG8_SA(1, 0), a3, voffA);
            PG8_WAIT_V(8); PG8_WAIT_L(0); PG8_BAR; PG8_MMA(1, 0, At, B0); PG8_MMA(1, 1, At, B1); PG8_BAR; PG8_SCHED;
            } else {
            PG8_LDB(B0, 0, 0); PG8_SCHED; PG8_LDA(At, 0, 0); PG8_STAGE(PG8_SA(1, 1), a1 + hstep, voffA);
            PG8_WAIT_L(8); PG8_BAR; PG8_WAIT_L(0); PG8_MMA(0, 0, At, B0); PG8_BAR; PG8_SCHED;
            PG8_LDB(B1, 0, 1); PG8_STAGE(PG8_SB(0, 0), b2, voffB);
            PG8_BAR; PG8_WAIT_L(0); PG8_MMA(0, 1, At, B1); PG8_BAR;
            PG8_LDA(At, 0, 1); PG8_STAGE(PG8_SA(0, 0), a2, voffA);
            PG8_BAR; PG8_WAIT_L(0); PG8_MMA(1, 0, At, B0); PG8_BAR; PG8_SCHED;
            PG8_STAGE(PG8_SB(0, 1), b2 + hstep, voffB);
            PG8_WAIT_V(6); PG8_BAR; PG8_MMA(1, 1, At, B1); PG8_BAR;
            PG8_LDB(B0, 1, 0); PG8_SCHED; PG8_LDA(At, 1, 0); PG8_STAGE(PG8_SA(0, 1), a2 + hstep, voffA);
            PG8_WAIT_L(8); PG8_BAR; PG8_WAIT_L(0); PG8_MMA(0, 0, At, B0); PG8_BAR; PG8_SCHED;
            PG8_LDB(B1, 1, 1); PG8_STAGE(PG8_SB(1, 0), b3, voffB);
            PG8_BAR; PG8_WAIT_L(0); PG8_MMA(0, 1, At, B1); PG8_BAR;
            PG8_LDA(At, 1, 1); PG8_STAGE(PG8_SA(1, 0), a3, voffA);
            PG8_BAR; PG8_WAIT_L(0); PG8_MMA(1, 0, At, B0); PG8_BAR; PG8_SCHED;
            PG8_STAGE(PG8_SB(1, 1), b3 + hstep, voffB);
            PG8_WAIT_V(6); PG8_BAR; PG8_MMA(1, 1, At, B1); PG8_BAR;
            }
        }
        if constexpr (ALIGN_EPI) { if (wr == 0) PG8_BAR; }
        if constexpr (!Epi::AFTER_DRAIN) { E(acc, cur, wr, wc, fr, fq); S.done(cur); }
        if (!has_next) break;
#pragma unroll
        for (int a = 0; a < 2; ++a)
#pragma unroll
            for (int b = 0; b < 2; ++b)
#pragma unroll
                for (int m = 0; m < 4; ++m)
#pragma unroll
                    for (int n = 0; n < 2; ++n) acc[a][b][m][n] = (f32x4){0.f, 0.f, 0.f, 0.f};
        cur = nxt; cA = nA; cB = nB; ++ui;
        if constexpr (ALIGN_EPI) { if (wr == 1) PG8_BAR; }
    }
    PG8_WAIT_V(0);
    if constexpr (!ALIGN_EPI) { if (wr == 0) PG8_BAR; }
    PG8_BAR;
    if constexpr (Epi::AFTER_DRAIN) { E.fused(acc, cur, wr, wc, fr, fq, lds, wid, lane); S.done(cur); }
#undef PG8_SA
#undef PG8_SB
#undef PG8_STAGE
#undef PG8_LDA
#undef PG8_LDB
#undef PG8_MMA
#undef PG8_WAIT_V
#undef PG8_WAIT_L
#undef PG8_BAR
#undef PG8_SCHED
}
}

constexpr int NWAVES = 8, NTHR = 512;
constexpr int DM = 2048, NTOK = 8192, NCTX = 4096, DFF = 8192, NLAYER = 4, NMODC = 12288;
constexpr float RMS_EPS = 1e-6f;
constexpr float LOG2E = 1.4426950408889634f;

constexpr size_t MiB = 1u << 20;
constexpr size_t WS_CTL = 0, CTL_ZERO_BYTES = 1 * MiB;
constexpr size_t WS_ROPE = 1 * MiB;
constexpr size_t WS_MOD = 2 * MiB;
constexpr size_t WS_MODP = 4 * MiB;
constexpr size_t WS_GATES = 12 * MiB;
constexpr size_t WS_W = 16 * MiB;
constexpr size_t W_AIN = WS_W, W_AOUT = W_AIN + 24 * MiB, W_BIN = W_AOUT + 8 * MiB, W_BOUT = W_BIN + 24 * MiB;
constexpr size_t W_CIN = W_BOUT + 8 * MiB, W_COUT = W_CIN + 24 * MiB, W_DIN = W_COUT + 8 * MiB, W_DOUT = W_DIN + 12 * MiB;
constexpr size_t W_FF1 = W_DOUT + 8 * MiB, W_FF2 = W_FF1 + 128 * MiB;
constexpr size_t WS_H = W_FF2 + 128 * MiB;
constexpr size_t WS_QKV = WS_H + 32 * MiB;
constexpr size_t WS_O = WS_QKV + 96 * MiB;
constexpr size_t WS_Y = WS_O + 32 * MiB;
constexpr size_t WS_U = WS_Y + 64 * MiB;
constexpr size_t WS_CAK = WS_U + 128 * MiB, WS_CAV = WS_CAK + 8 * MiB, WS_CCK = WS_CAV + 8 * MiB, WS_CCV = WS_CCK + 8 * MiB;
constexpr size_t WS_CDK = WS_CCV + 8 * MiB, WS_CDV = WS_CDK + 2 * MiB, WS_SC = WS_CDV + 2 * MiB;
constexpr size_t WS_END = WS_SC + 4 * MiB;
constexpr int CW_BAR = 4096;

constexpr size_t O_YP = 0, O_AK = 16777216, O_AV = 25165824, O_BC = 33554432, O_BN = 41943040, O_BM = 41975808, O_CK = 41976064, O_CV = 50364672, O_DK = 58753280, O_DV = 60850432, O_END = 62947584;

constexpr int LDS_PHASE_BYTES = 162816;
constexpr int MISC_OFF = LDS_PHASE_BYTES;
constexpr int LDS_BYTES = LDS_PHASE_BYTES + 256;

#define LAS __attribute__((address_space(3)))
#define DI __device__ __forceinline__
typedef unsigned short bf16;
typedef short bf16x8 __attribute__((ext_vector_type(8)));
typedef short s16x4 __attribute__((ext_vector_type(4)));
typedef float f32x16 __attribute__((ext_vector_type(16)));
typedef float f32x4 __attribute__((ext_vector_type(4)));
typedef float f32x2 __attribute__((ext_vector_type(2)));
typedef unsigned u32x4 __attribute__((ext_vector_type(4)));
typedef unsigned u32x2 __attribute__((ext_vector_type(2)));
typedef __bf16 bf16x2_t __attribute__((ext_vector_type(2)));
typedef LAS char* ldsp;

DI unsigned pk2(float lo, float hi) { f32x2 v = {lo, hi}; bf16x2_t b = __builtin_convertvector(v, bf16x2_t); return __builtin_bit_cast(unsigned, b); }
DI float bf2f(unsigned short v) { return __uint_as_float(((unsigned)v) << 16); }
DI float bflo(unsigned w) { return __uint_as_float(w << 16); }
DI float bfhi(unsigned w) { return __uint_as_float(w & 0xffff0000u); }
DI float ex2(float x) { return __builtin_amdgcn_exp2f(x); }
DI float wave_sum(float v) {
#pragma unroll
    for (int o = 1; o < 64; o <<= 1) v += __shfl_xor(v, o);
    return v;
}
DI float hmax(float x) { auto rr = __builtin_amdgcn_permlane32_swap(__float_as_uint(x), __float_as_uint(x), false, false); return fmaxf(__uint_as_float(rr[0]), __uint_as_float(rr[1])); }
DI float hsum(float x) { auto rr = __builtin_amdgcn_permlane32_swap(__float_as_uint(x), __float_as_uint(x), false, false); return __uint_as_float(rr[0]) + __uint_as_float(rr[1]); }
DI int crow(int r, int hi) { return (r & 3) + 8 * (r >> 2) + 4 * hi; }

#define XB_TMO      128
#define XB_XCNT(j)  (256  + 64 * (j))
#define XB_XSUB(j)  (1280 + 64 * (j))
#define XB_XGEN(j)  (2304 + 64 * (j))
#define XB_TOP      3328
#define XB_TOPGEN   3392
#define XCD_BAR_WORDS 3456
#define XB_SPIN_CAP (1u << 18)
__device__ __forceinline__ unsigned xb_ld(unsigned* p)              { return __hip_atomic_load(p, __ATOMIC_RELAXED, __HIP_MEMORY_SCOPE_AGENT); }
__device__ __forceinline__ unsigned xb_add(unsigned* p, unsigned v) { return __hip_atomic_fetch_add(p, v, __ATOMIC_RELAXED, __HIP_MEMORY_SCOPE_AGENT); }
__device__ __forceinline__ unsigned xb_xcc_id() { return (unsigned)__builtin_amdgcn_s_getreg((3 << 11) | 20) & 0xFu; }
#define XB_SPIN(cond, bar) do { unsigned _sp = 0; while (cond) { __builtin_amdgcn_s_sleep(1); \
    if ((++_sp & 255u) == 0u) { if (xb_ld(&(bar)[XB_TMO])) break; if (_sp > XB_SPIN_CAP) { atomicAdd(&(bar)[XB_TMO], 1u); break; } } } } while (0)
struct XcdBarrier { unsigned* bar; unsigned x; volatile LAS unsigned* st; };
__device__ __forceinline__ XcdBarrier xcd_barrier_post(unsigned* bar, volatile LAS unsigned* st) {
    XcdBarrier b; b.bar = bar; b.x = xb_xcc_id(); b.st = st;
    if (threadIdx.x == 0) (void)xb_add(&bar[XB_XCNT(b.x)], 1u);
    return b;
}
__device__ __forceinline__ void xcd_barrier_complete(unsigned* bar, unsigned x, unsigned& nloc, unsigned& nx) {
    const unsigned G = gridDim.x * gridDim.y * gridDim.z;
    unsigned sum, cnt, mine, sp = 0u;
    for (;;) {
        sum = 0u; cnt = 0u; mine = 0u;
#pragma unroll
        for (unsigned j = 0; j < 16; ++j) { const unsigned c = xb_ld(&bar[XB_XCNT(j)]); sum += c; cnt += (c > 0u) ? 1u : 0u; mine = (j == x) ? c : mine; }
        if (sum == G) break;
        __builtin_amdgcn_s_sleep(1);
        if ((++sp & 255u) == 0u) { if (xb_ld(&bar[XB_TMO])) break; if (sp > XB_SPIN_CAP) { atomicAdd(&bar[XB_TMO], 1u); break; } }
    }
    nloc = mine > 0u ? mine : 1u; nx = cnt > 0u ? cnt : 1u;
}
__device__ __forceinline__ void xcd_barrier(const XcdBarrier& b) {
    asm volatile("s_waitcnt vmcnt(0)" ::: "memory");
    __syncthreads();
    if (threadIdx.x == 0) {
        unsigned* bar = b.bar;
        __builtin_amdgcn_s_waitcnt(0);
        unsigned nloc = b.st[0], nx = b.st[1];
        if (nloc == 0u) { xcd_barrier_complete(bar, b.x, nloc, nx); b.st[0] = nloc; b.st[1] = nx; }
        const unsigned old = xb_add(&bar[XB_XSUB(b.x)], 1u);
        const unsigned gen = old / nloc;
        if (old + 1u == (gen + 1u) * nloc) {
            __builtin_amdgcn_fence(__ATOMIC_RELEASE, "agent");
            asm volatile("s_waitcnt vmcnt(0)" ::: "memory");
            const unsigned og = xb_add(&bar[XB_TOP], 1u);
            const unsigned tg = og / nx;
            if (og + 1u == (tg + 1u) * nx) xb_add(&bar[XB_TOPGEN], 1u);
            else XB_SPIN(xb_ld(&bar[XB_TOPGEN]) == tg, bar);
            __builtin_amdgcn_fence(__ATOMIC_ACQUIRE, "agent");
            xb_add(&bar[XB_XGEN(b.x)], 1u);
            asm volatile("s_waitcnt vmcnt(0)" ::: "memory");
        } else {
            XB_SPIN(xb_ld(&bar[XB_XGEN(b.x)]) == gen, bar);
            __builtin_amdgcn_fence(__ATOMIC_ACQUIRE, "agent");
            asm volatile("s_waitcnt vmcnt(0)" ::: "memory");
        }
    }
    __syncthreads();
}

struct Args { const float* in[32]; float* out; unsigned char* ws; int ph_lo, ph_hi; };

struct TrItem { const float* W; bf16* WT; int K, ld, k0, n0; };
DI void tr_set(TrItem& t, const float* W, int K, int N, int ld, bf16* WT, int item) { const int nblk = N / 32, kb = item / nblk, nb = item % nblk; t.W = W; t.WT = WT; t.K = K; t.ld = ld; t.k0 = 64 * kb; t.n0 = 32 * nb; }
DI void tr_load(const TrItem& t, int lane, float (&v)[32]) {
#pragma unroll
    for (int i = 0; i < 32; ++i) { const int kk = 2 * i + (lane >> 5); v[i] = t.W[(size_t)(t.k0 + kk) * t.ld + t.n0 + (lane & 31)]; }
}
DI void tr_store(const TrItem& t, LAS float* scr, int lane, const float (&v)[32]) {
#pragma unroll
    for (int i = 0; i < 32; ++i) { const int kk = 2 * i + (lane >> 5); scr[kk * 33 + (lane & 31)] = v[i]; }
    asm volatile("s_waitcnt lgkmcnt(0)" ::: "memory");
    const int c = lane & 7;
#pragma unroll
    for (int j = 0; j < 4; ++j) { const int n = (lane >> 3) + 8 * j; const LAS float* s = scr + (8 * c) * 33 + n;
        u32x4 o; o.x = pk2(s[0 * 33], s[1 * 33]); o.y = pk2(s[2 * 33], s[3 * 33]); o.z = pk2(s[4 * 33], s[5 * 33]); o.w = pk2(s[6 * 33], s[7 * 33]);
        *(u32x4*)(t.WT + (size_t)(t.n0 + n) * t.K + t.k0 + 8 * c) = o; }
    asm volatile("s_waitcnt lgkmcnt(0)" ::: "memory");
}
DI void cvt_flat(const float* src, bf16* dst, size_t n8, size_t gtid, size_t nthr) {
    for (size_t i = gtid; i < n8; i += nthr) { const f32x4 a = *(const f32x4*)(src + i * 8), b = *(const f32x4*)(src + i * 8 + 4);
        u32x4 o; o.x = pk2(a[0], a[1]); o.y = pk2(a[2], a[3]); o.z = pk2(b[0], b[1]); o.w = pk2(b[2], b[3]); *(u32x4*)(dst + i * 8) = o; }
}
DI float silu(float x) { return x / (1.f + __expf(-x)); }

DI void p0a_prologue(const Args& A, ldsp lds, int G, int bid, int tid) {
    const int lane = tid & 63, wave = tid >> 6;
    unsigned char* ws = A.ws;
    const int gw = bid * NWAVES + wave, NGW = G * NWAVES;
    LAS float* scr = (LAS float*)(lds + wave * 16384);
    constexpr int I_IN = (DM / 64) * (6144 / 32), I_OUT = (DM / 64) * (DM / 32), I_DIN = (DM / 64) * (3072 / 32), I_F1 = (DM / 64) * (DFF / 32), I_F2 = (DFF / 64) * (DM / 32);
    constexpr int NITEMS = 3 * I_IN + 4 * I_OUT + I_DIN + 4 * I_F1 + 4 * I_F2;
    auto decode = [&](int it, TrItem& t) {
        int r = it; unsigned char* w = ws;
        if (r < I_IN) { tr_set(t, A.in[18], DM, 6144, 6144, (bf16*)(w + W_AIN), r); return; } r -= I_IN;
        if (r < I_OUT) { tr_set(t, A.in[19], DM, DM, DM, (bf16*)(w + W_AOUT), r); return; } r -= I_OUT;
        if (r < I_IN) { tr_set(t, A.in[22], DM, 6144, 6176, (bf16*)(w + W_BIN), r); return; } r -= I_IN;
        if (r < I_OUT) { tr_set(t, A.in[24], DM, DM, DM, (bf16*)(w + W_BOUT), r); return; } r -= I_OUT;
        if (r < I_IN) { tr_set(t, A.in[26], DM, 6144, 6144, (bf16*)(w + W_CIN), r); return; } r -= I_IN;
        if (r < I_OUT) { tr_set(t, A.in[27], DM, DM, DM, (bf16*)(w + W_COUT), r); return; } r -= I_OUT;
        if (r < I_DIN) { tr_set(t, A.in[29], DM, 3072, 3072, (bf16*)(w + W_DIN), r); return; } r -= I_DIN;
        if (r < I_OUT) { tr_set(t, A.in[30], DM, DM, DM, (bf16*)(w + W_DOUT), r); return; } r -= I_OUT;
        if (r < 4 * I_F1) { const int L = r / I_F1; r -= L * I_F1; tr_set(t, A.in[16] + (size_t)L * DM * DFF, DM, DFF, DFF, (bf16*)(w + W_FF1) + (size_t)L * DM * DFF, r); return; } r -= 4 * I_F1;
        { const int L = r / I_F2; r -= L * I_F2; tr_set(t, A.in[17] + (size_t)L * DM * DFF, DFF, DM, DM, (bf16*)(w + W_FF2) + (size_t)L * DM * DFF, r); }
    };
    for (int it = gw; it < NITEMS; it += NGW) { TrItem cur; float va[32]; decode(it, cur); tr_load(cur, lane, va); tr_store(cur, scr, lane, va); }
    const size_t gtid = (size_t)bid * NTHR + tid, nthr = (size_t)G * NTHR;
    cvt_flat(A.in[2], (bf16*)(ws + WS_CAK), (size_t)4 * 512 * 2048 / 8, gtid, nthr);
    cvt_flat(A.in[3], (bf16*)(ws + WS_CAV), (size_t)4 * 512 * 2048 / 8, gtid, nthr);
    cvt_flat(A.in[7], (bf16*)(ws + WS_CCK), (size_t)4 * 512 * 2048 / 8, gtid, nthr);
    cvt_flat(A.in[8], (bf16*)(ws + WS_CCV), (size_t)4 * 512 * 2048 / 8, gtid, nthr);
    cvt_flat(A.in[9], (bf16*)(ws + WS_CDK), (size_t)4 * 512 * 512 / 8, gtid, nthr);
    cvt_flat(A.in[10], (bf16*)(ws + WS_CDV), (size_t)4 * 512 * 512 / 8, gtid, nthr);
    cvt_flat(A.in[4], (bf16*)(ws + WS_SC), (size_t)4 * 2 * 8 * 256 * 128 / 8, gtid, nthr);
    if (gtid < 1024) {
        const int pos = (int)gtid >> 4, i = (int)gtid & 15;
        double inv = 1.0; for (int k = 0; k < i; ++k) inv *= 0.5623413251903491;
        const double rev = (double)pos * inv * 0.15915494309189535;
        const double fr = rev - floor(rev);
        float* rt = (float*)(ws + WS_ROPE);
        rt[gtid * 2] = __builtin_amdgcn_cosf((float)fr); rt[gtid * 2 + 1] = __builtin_amdgcn_sinf((float)fr);
    }
    float* modp = (float*)(ws + WS_MODP);
    for (int un = gw; un < 4 * 48 * 8; un += NGW) {
        const int L = un / 384, rem = un % 384, cb = rem >> 3, ks = rem & 7;
        const float* wm = A.in[13] + ((size_t)L * DM + ks * 256) * NMODC + cb * 256 + lane * 4;
        f32x4 acc[5];
#pragma unroll
        for (int c = 0; c < 5; ++c) acc[c] = (f32x4){0.f, 0.f, 0.f, 0.f};
#pragma unroll 8
        for (int k = 0; k < 256; ++k) {
            const f32x4 w = *(const f32x4*)(wm + (size_t)k * NMODC);
            const int kk = ks * 256 + k;
            const float s0 = silu(A.in[12][kk]);
            acc[0] += w * s0;
#pragma unroll
            for (int c = 1; c < 5; ++c) { const float s = silu(A.in[11][(c - 1) * DM + kk]); acc[c] += w * s; }
        }
#pragma unroll
        for (int c = 0; c < 5; ++c) *(f32x4*)(modp + ((size_t)(L * 8 + ks) * 5 + c) * NMODC + cb * 256 + lane * 4) = acc[c];
    }
}
DI void p0b_modreduce(const Args& A, int G, int bid, int tid) {
    const float* modp = (const float*)(A.ws + WS_MODP); float* mod = (float*)(A.ws + WS_MOD);
    for (int i = bid * NTHR + tid; i < 4 * 5 * NMODC; i += G * NTHR) {
        const int L = i / (5 * NMODC), rem = i % (5 * NMODC), c = rem / NMODC, col = rem % NMODC;
        float s = A.in[14][L * NMODC + col];
#pragma unroll
        for (int ks = 0; ks < 8; ++ks) s += modp[((size_t)(L * 8 + ks) * 5 + c) * NMODC + col];
        mod[i] = s;
    }
}

struct RowP {
    const bf16* Y;
    int mod_gate;
    int Lg;
    int gpost;
    int has_next;
    int Ln;
    int gpre;
    int mod_shift;
    int do_gates;
    int dry;
};
DI void row_load(const Args& A, const RowP& P, int r, int lane, f32x4 (&x)[8], u32x2 (&yw)[8]) {
    const float* src = P.Y == nullptr ? (r < NCTX ? A.in[0] + (size_t)r * DM : A.in[1] + (size_t)(r - NCTX) * DM) : A.out + (size_t)r * DM;
#pragma unroll
    for (int j = 0; j < 8; ++j) x[j] = *(const f32x4*)(src + 4 * lane + 256 * j);
    if (P.Y != nullptr) {
#pragma unroll
        for (int j = 0; j < 8; ++j) yw[j] = *(const u32x2*)(P.Y + (size_t)r * DM + 4 * lane + 256 * j);
    }
}
DI void row_proc(const Args& A, const RowP& P, ldsp lds, int r, int slot, int lane, int wave, f32x4 (&x)[8], const u32x2 (&yw)[8]) {
    bf16* H = (bf16*)(A.ws + WS_H);
    float* Xw = P.dry ? (float*)(A.ws + WS_U) : A.out; bf16* Hw = P.dry ? (bf16*)(A.ws + WS_U + 64 * MiB) : H;
    const float* mod = (const float*)(A.ws + WS_MOD); const float* gn = A.in[15];
    const int cond = r < NCTX ? 0 : 1 + ((r - NCTX) >> 10);
    if (P.Y != nullptr) {
        f32x4 y[8]; float ss = 0.f;
#pragma unroll
        for (int j = 0; j < 8; ++j) { y[j] = (f32x4){bflo(yw[j].x), bfhi(yw[j].x), bflo(yw[j].y), bfhi(yw[j].y)}; ss += (y[j][0] * y[j][0] + y[j][1] * y[j][1]) + (y[j][2] * y[j][2] + y[j][3] * y[j][3]); }
        const float rs = 1.0f / sqrtf(wave_sum(ss) * (1.f / DM) + RMS_EPS);
        const float* gate = mod + ((size_t)(P.Lg * 5 + cond) * 6 + P.mod_gate) * DM; const float* gp = gn + (size_t)P.gpost * DM;
#pragma unroll
        for (int j = 0; j < 8; ++j) { const f32x4 gt = *(const f32x4*)(gate + 4 * lane + 256 * j), gg = *(const f32x4*)(gp + 4 * lane + 256 * j);
            x[j] = x[j] + gt * (y[j] * rs * gg); }
    }
#pragma unroll
    for (int j = 0; j < 8; ++j) *(f32x4*)(Xw + (size_t)r * DM + 4 * lane + 256 * j) = x[j];
    if (P.has_next) {
        float ss = 0.f;
#pragma unroll
        for (int j = 0; j < 8; ++j) ss += (x[j][0] * x[j][0] + x[j][1] * x[j][1]) + (x[j][2] * x[j][2] + x[j][3] * x[j][3]);
        const float rs = 1.0f / sqrtf(wave_sum(ss) * (1.f / DM) + RMS_EPS);
        const float* sh = mod + ((size_t)(P.Ln * 5 + cond) * 6 + P.mod_shift) * DM; const float* sc = sh + DM; const float* gp = gn + (size_t)P.gpre * DM;
#pragma unroll
        for (int j = 0; j < 8; ++j) { const f32x4 gg = *(const f32x4*)(gp + 4 * lane + 256 * j), s1 = *(const f32x4*)(sc + 4 * lane + 256 * j), s0 = *(const f32x4*)(sh + 4 * lane + 256 * j);
            x[j] = (x[j] * rs * gg) * (1.0f + s1) + s0;
            u32x2 o; o.x = pk2(x[j][0], x[j][1]); o.y = pk2(x[j][2], x[j][3]);
            *(u32x2*)(Hw + (size_t)r * DM + 4 * lane + 256 * j) = o; }
            if (P.do_gates && !P.dry && lane == 0) ((LAS float*)(lds + 147456))[slot] = rs;
    }
}
DI float reduce32(float (&a)[32], int lane) {
#pragma unroll
    for (int i = 0; i < 16; ++i) { const bool hi = lane & 32; const float keep = hi ? a[i + 16] : a[i], send = hi ? a[i] : a[i + 16]; a[i] = keep + __shfl_xor(send, 32); }
#pragma unroll
    for (int i = 0; i < 8; ++i) { const bool hi = lane & 16; const float keep = hi ? a[i + 8] : a[i], send = hi ? a[i] : a[i + 8]; a[i] = keep + __shfl_xor(send, 16); }
#pragma unroll
    for (int i = 0; i < 4; ++i) { const bool hi = lane & 8; const float keep = hi ? a[i + 4] : a[i], send = hi ? a[i] : a[i + 4]; a[i] = keep + __shfl_xor(send, 8); }
#pragma unroll
    for (int i = 0; i < 2; ++i) { const bool hi = lane & 4; const float keep = hi ? a[i + 2] : a[i], send = hi ? a[i] : a[i + 2]; a[i] = keep + __shfl_xor(send, 4); }
    { const bool hi = lane & 2; const float keep = hi ? a[1] : a[0], send = hi ? a[0] : a[1]; a[0] = keep + __shfl_xor(send, 2); }
    return a[0] + __shfl_xor(a[0], 1);
}
DI void row_phase(const Args& A, const RowP& P, ldsp lds, int G, int bid, int tid) {
    const int lane = tid & 63, wave = tid >> 6;
    const int gw = bid * NWAVES + wave, NGW = G * NWAVES;
    int k = 0;
    for (int r = gw; r < NTOK; r += 2 * NGW, k += 2) {
        f32x4 xa[8], xb[8]; u32x2 ya[8], yb[8];
        const int r2 = r + NGW;
        row_load(A, P, r, lane, xa, ya);
        if (r2 < NTOK) row_load(A, P, r2, lane, xb, yb);
        row_proc(A, P, lds, r, (wave * 4 + k) & 31, lane, wave, xa, ya);
        if (r2 < NTOK) row_proc(A, P, lds, r2, (wave * 4 + k + 1) & 31, lane, wave, xb, yb);
    }
    if (P.do_gates && !P.dry && NTOK <= 4 * NGW) {
        LAS float* Wl = (LAS float*)lds; LAS float* rsl = (LAS float*)(lds + 147456); LAS float* gpl = rsl + 32;
        const float* Wg = A.in[22] + 6144; const float* mod = (const float*)(A.ws + WS_MOD); const float* gn = A.in[15];
        asm volatile("s_waitcnt vmcnt(0)" ::: "memory");
        __syncthreads();
        for (int half = 0; half < 2; ++half) {
            { f32x4 t[16];
#pragma unroll
              for (int i = 0; i < 16; ++i) { const int idx = tid + NTHR * i, c = idx >> 3, q = idx & 7; t[i] = *(const f32x4*)(Wg + (size_t)(half * 1024 + c) * 6176 + 4 * q); }
#pragma unroll
              for (int i = 0; i < 16; ++i) { const int idx = tid + NTHR * i, c = idx >> 3, q = idx & 7; *(LAS f32x4*)(Wl + c * 36 + 4 * q) = t[i]; } }
            __syncthreads();
            for (int kk = 0; kk < 4; ++kk) {
                const int r = gw + kk * NGW;
                if (r < NTOK) {
                    const int cond = r < NCTX ? 0 : 1 + ((r - NCTX) >> 10);
                    const float rs = rsl[wave * 4 + kk];
                    const float* xr = A.out + (size_t)r * DM + half * 1024; const float* gpv = gn + (size_t)P.gpre * DM + half * 1024;
                    const float* sh = mod + ((size_t)(P.Ln * 5 + cond) * 6 + P.mod_shift) * DM + half * 1024; const float* sc = sh + DM;
                    f32x4 av[8];
#pragma unroll
                    for (int q = 0; q < 8; ++q) av[q] = (f32x4){0.f, 0.f, 0.f, 0.f};
                    float hv[16];
#pragma unroll
                    for (int i = 0; i < 16; ++i) hv[i] = __hip_atomic_load(xr + lane + 64 * i, __ATOMIC_RELAXED, __HIP_MEMORY_SCOPE_AGENT);
#pragma unroll
                    for (int i = 0; i < 16; ++i) { const int c = lane + 64 * i; hv[i] = (hv[i] * rs * gpv[c]) * (1.0f + sc[c]) + sh[c]; }
#pragma unroll
                    for (int i = 0; i < 16; ++i) { const LAS f32x4* wrow = (const LAS f32x4*)(Wl + (lane + 64 * i) * 36);
#pragma unroll
                        for (int q = 0; q < 8; ++q) av[q] += wrow[q] * hv[i]; }
                    float acc[32];
#pragma unroll
                    for (int q = 0; q < 8; ++q) { acc[4 * q] = av[q][0]; acc[4 * q + 1] = av[q][1]; acc[4 * q + 2] = av[q][2]; acc[4 * q + 3] = av[q][3]; }
                    const float tot = reduce32(acc, lane); const int g = (lane >> 1) & 31;
                    if ((lane & 1) == 0) { if (half == 0) gpl[(wave * 4 + kk) * 32 + g] = tot; else ((float*)(A.ws + WS_GATES))[(size_t)r * 32 + g] = gpl[(wave * 4 + kk) * 32 + g] + tot + A.in[23][g]; }
                }
            }
            __syncthreads();
        }
    }
}

typedef short v4i16_t __attribute__((ext_vector_type(4)));
DI s16x4 tr_read(ldsp p) { return __builtin_bit_cast(s16x4, __builtin_amdgcn_ds_read_tr16_b64_v4i16((LAS v4i16_t*)p)); }
template <int OFF> DI s16x4 tr_asm(unsigned addr) { s16x4 r; asm volatile("ds_read_b64_tr_b16 %0, %1 offset:%2" : "=&v"(r) : "v"(addr), "i"(OFF) : "memory"); return r; }
#define MFMA32(a, b, c) __builtin_amdgcn_mfma_f32_32x32x16_bf16((a), (b), (c), 0, 0, 0)

template <int NS> DI void qk_tile(f32x16& s, ldsp kaddr, const bf16x8 (&qr)[NS]) {
#pragma unroll
    for (int i = 0; i < 16; ++i) s[i] = 0.f;
#pragma unroll
    for (int d0 = 0; d0 < NS; ++d0) { const bf16x8 a = *(const LAS bf16x8*)(kaddr + 32 * d0); s = MFMA32(a, qr[d0], s); }
}
template <int NS> DI void qk_tile_lq(f32x16& s, ldsp kaddr, ldsp qaddr) {
#pragma unroll
    for (int i = 0; i < 16; ++i) s[i] = 0.f;
#pragma unroll
    for (int d0 = 0; d0 < NS; ++d0) { const bf16x8 a = *(const LAS bf16x8*)(kaddr + 32 * d0); const bf16x8 b = *(const LAS bf16x8*)(qaddr + 32 * d0); s = MFMA32(a, b, s); }
}
template <int S> DI bf16x8 pack8(const f32x16& p) {
    u32x4 w; w.x = pk2(p[8 * S + 0], p[8 * S + 1]); w.y = pk2(p[8 * S + 2], p[8 * S + 3]); w.z = pk2(p[8 * S + 4], p[8 * S + 5]); w.w = pk2(p[8 * S + 6], p[8 * S + 7]);
    return __builtin_bit_cast(bf16x8, w);
}
template <int ND> DI void pv_tile(f32x16 (&o)[ND], ldsp vaddr, int pvb, bf16x8 p0, bf16x8 p1) {
#pragma unroll
    for (int d0 = 0; d0 < ND; ++d0) {
        const s16x4 l0 = tr_read(vaddr + 64 * d0), h0 = tr_read(vaddr + 8 * pvb + 64 * d0);
        const s16x4 l1 = tr_read(vaddr + 16 * pvb + 64 * d0), h1 = tr_read(vaddr + 24 * pvb + 64 * d0);
        const bf16x8 a0 = {l0[0], l0[1], l0[2], l0[3], h0[0], h0[1], h0[2], h0[3]};
        const bf16x8 a1 = {l1[0], l1[1], l1[2], l1[3], h1[0], h1[1], h1[2], h1[3]};
        o[d0] = MFMA32(a0, p0, o[d0]);
        o[d0] = MFMA32(a1, p1, o[d0]);
    }
}
template <int NC> DI void stage_ld(bf16x8 (&r)[NC / 64], const bf16* src, size_t gs, int tid) {
#pragma unroll
    for (int i = 0; i < NC / 64; ++i) { const int idx = tid + NTHR * i, row = idx / (NC / 8), c8 = idx % (NC / 8); r[i] = *(const bf16x8*)(src + (size_t)row * gs + c8 * 8); }
}
template <int NC> DI void stage_st(const bf16x8 (&r)[NC / 64], ldsp dst, int pb, int tid) {
#pragma unroll
    for (int i = 0; i < NC / 64; ++i) { const int idx = tid + NTHR * i, row = idx / (NC / 8), c8 = idx % (NC / 8); *(LAS bf16x8*)(dst + row * pb + c8 * 16) = r[i]; }
}

template <int RB> DI int fK(int row) { return RB == 128 ? ((row >> 1) & 7) : (row & 15); }
template <int RB> DI int fV(int row) { return RB == 128 ? (((row >> 1) & 1) << 2) : ((row & 3) << 2); }
template <int RB, bool ISV> DI void dma_tile(ldsp dst, const bf16* src, size_t gs, int wave, int lane) {
    constexpr int NI = 64 * RB / 1024 / 8, SPR = RB / 16, RPP = 1024 / RB;
    const int pos = wave * 64 + lane, row = pos / SPR, sl = pos % SPR, g = sl ^ (ISV ? fV<RB>(row) : fK<RB>(row));
    const bf16* lp = src + (size_t)row * gs + g * 8;
#pragma unroll
    for (int i = 0; i < NI; ++i)
        __builtin_amdgcn_global_load_lds((const unsigned*)(lp + (size_t)(8 * i * RPP) * gs), (LAS unsigned*)(dst + (wave + 8 * i) * 1024), 16, 0, 0);
}
#define VM_WAIT_N(n) asm volatile("s_waitcnt vmcnt(" #n ")" ::: "memory")
template <int PIECES> DI void wait_chunks(int rem) {
    if (rem >= 2) { if constexpr (PIECES == 2) VM_WAIT_N(4); else if constexpr (PIECES == 4) VM_WAIT_N(8); else VM_WAIT_N(12); }
    else if (rem == 1) { if constexpr (PIECES == 2) VM_WAIT_N(2); else if constexpr (PIECES == 4) VM_WAIT_N(4); else VM_WAIT_N(6); }
    else VM_WAIT_N(0);
}

template <int DQK, int KW, int DV, class Pol>
DI void attn_loop(ldsp lds, const Pol& P, const bf16x8 (&qr)[DQK / 16], f32x16 (&o)[DV / 32], float& m, float& l, int tid) {
    constexpr int RBK = KW * 2, RBV = DV * 2, KBYTES = 64 * RBK, VBYTES = 64 * RBV, BUF = KBYTES + VBYTES, NS = 4, PD = 3;
    constexpr int PIECES = (KBYTES + VBYTES) / 8192;
    const int lane = tid & 63, wave = __builtin_amdgcn_readfirstlane(tid >> 6), r32 = lane & 31, h2 = lane >> 5, i16 = lane & 15, tq = i16 >> 2, tp = i16 & 3, blk = (lane >> 4) & 1;
    const int kx = fK<RBK>(r32), kg0 = P.kcol / 8 + h2;
    const int krow = r32 * RBK;
    const int vbase = (4 * h2 + tq) * RBV + 32 * blk + 8 * tp;
    const int vx = RBV == 128 ? (tq >> 1) : tq;
    const int n = P.nchunks;
    asm volatile("s_waitcnt vmcnt(0) lgkmcnt(0)" ::: "memory");
#pragma unroll
    for (int k = 0; k < PD; ++k) if (k < n) { const bf16 *kp, *vp; size_t st; P.src(k, kp, vp, st); ldsp sb = lds + k * BUF; dma_tile<RBK, false>(sb, kp, st, wave, lane); dma_tile<RBV, true>(sb + KBYTES, vp, st, wave, lane); }
    for (int c = 0; c < n; ++c) {
        wait_chunks<PIECES>(n - 1 - c < PD - 1 ? n - 1 - c : PD - 1);
        __builtin_amdgcn_s_barrier(); asm volatile("" ::: "memory");
        if (c + PD < n) { const bf16 *kp, *vp; size_t st; P.src(c + PD, kp, vp, st); ldsp sb = lds + ((c + PD) & (NS - 1)) * BUF; dma_tile<RBK, false>(sb, kp, st, wave, lane); dma_tile<RBV, true>(sb + KBYTES, vp, st, wave, lane); }
        ldsp kb = lds + (c & (NS - 1)) * BUF; ldsp vb = kb + KBYTES;
        if (P.active(c)) {
#pragma unroll
            for (int kt = 0; kt < 2; ++kt) {
                f32x16 s0;
#pragma unroll
                for (int i = 0; i < 16; ++i) s0[i] = 0.f;
#pragma unroll
                for (int d0 = 0; d0 < DQK / 16; ++d0) { const bf16x8 a = *(const LAS bf16x8*)(kb + 32 * kt * RBK + krow + (((kg0 + 2 * d0) ^ kx) << 4)); s0 = MFMA32(a, qr[d0], s0); }
                P.fix(c, kt, s0);
                float mx = s0[0];
#pragma unroll
                for (int r = 1; r < 16; ++r) mx = fmaxf(mx, s0[r]);
                mx = hmax(mx) * P.sc2;
                if (!__all(mx - m <= 8.0f)) {
                    const float mn = fmaxf(m, mx), alpha = ex2(m - mn); m = mn; l *= alpha;
#pragma unroll
                    for (int d0 = 0; d0 < DV / 32; ++d0)
#pragma unroll
                        for (int r = 0; r < 16; ++r) o[d0][r] *= alpha;
                }
                float ps = 0.f;
#pragma unroll
                for (int r = 0; r < 16; ++r) { s0[r] = ex2(fmaf(s0[r], P.sc2, -m)); ps += s0[r]; }
                l += hsum(ps);
                const bf16x8 p0 = pack8<0>(s0), p1 = pack8<1>(s0);
                const unsigned va0 = (unsigned)(__UINTPTR_TYPE__)vb + (unsigned)((32 * kt) * RBV + vbase);
#pragma unroll
                for (int dp = 0; dp < DV / 64; ++dp) {
                    const unsigned a = va0 + 64 * ((2 * dp) ^ vx), b = va0 + 64 * ((2 * dp + 1) ^ vx);
                    const s16x4 l0 = tr_asm<0>(a), h0 = tr_asm<8 * RBV>(a), l1 = tr_asm<16 * RBV>(a), h1 = tr_asm<24 * RBV>(a);
                    const s16x4 m0 = tr_asm<0>(b), n0 = tr_asm<8 * RBV>(b), m1 = tr_asm<16 * RBV>(b), n1 = tr_asm<24 * RBV>(b);
                    asm volatile("s_waitcnt lgkmcnt(0)" ::: "memory"); __builtin_amdgcn_sched_barrier(0);
                    const bf16x8 a0 = {l0[0], l0[1], l0[2], l0[3], h0[0], h0[1], h0[2], h0[3]};
                    const bf16x8 a1 = {l1[0], l1[1], l1[2], l1[3], h1[0], h1[1], h1[2], h1[3]};
                    const bf16x8 b0 = {m0[0], m0[1], m0[2], m0[3], n0[0], n0[1], n0[2], n0[3]};
                    const bf16x8 b1 = {m1[0], m1[1], m1[2], m1[3], n1[0], n1[1], n1[2], n1[3]};
                    o[2 * dp] = MFMA32(a0, p0, o[2 * dp]);
                    o[2 * dp + 1] = MFMA32(b0, p0, o[2 * dp + 1]);
                    o[2 * dp] = MFMA32(a1, p1, o[2 * dp]);
                    o[2 * dp + 1] = MFMA32(b1, p1, o[2 * dp + 1]);
                }
            }
        }
    }
    asm volatile("s_waitcnt lgkmcnt(0)" ::: "memory"); __builtin_amdgcn_s_barrier(); asm volatile("" ::: "memory");
}
template <int ND> DI void store_ot(const f32x16 (&o)[ND], float inv, bf16* orow, int h2) {
#pragma unroll
    for (int d0 = 0; d0 < ND; ++d0)
#pragma unroll
        for (int g = 0; g < 4; ++g) { u32x2 w; w.x = pk2(o[d0][4 * g] * inv, o[d0][4 * g + 1] * inv); w.y = pk2(o[d0][4 * g + 2] * inv, o[d0][4 * g + 3] * inv);
            *(u32x2*)(orow + 32 * d0 + 8 * g + 4 * h2) = w; }
}

struct PolA {
    static constexpr float sc2 = 0.125f * LOG2E;
    int nchunks, kcol; const bf16* QKV; const bf16* CK; const bf16* CV; int b, h, latent;
    DI void src(int c, const bf16*& kp, const bf16*& vp, size_t& st) const {
        if (latent && c < 8) { const size_t off = ((size_t)(b * 512 + 64 * c) * 16 + h) * 128; kp = CK + off; vp = CV + off; st = 2048; }
        else { const int row = latent ? NCTX + b * 1024 + 64 * (c - 8) : b * 256 + 64 * c; kp = QKV + (size_t)row * 6144 + 2048 + h * 128; vp = kp + 2048; st = 6144; }
    }
    DI bool active(int) const { return true; }
    DI void fix(int, int, f32x16&) const {}
};
DI void phaseA(const Args& A, ldsp lds, int G, int bid, int tid) {
    const int lane = tid & 63, wave = tid >> 6, r32 = lane & 31, h2 = lane >> 5, j = wave >> 2, wq = wave & 3;
    const bf16* QKV = (const bf16*)(A.ws + WS_QKV); bf16* O = (bf16*)(A.ws + WS_O);
    const float lam_init = 0.2f;
    LAS float* xb = (LAS float*)lds;
    for (int u = bid; u < 1024; u += G) {
        PolA P; P.QKV = QKV; P.CK = (const bf16*)(A.ws + WS_CAK); P.CV = (const bf16*)(A.ws + WS_CAV); P.kcol = 64 * j;
        int rowbase;
        if (u < 512) { const int uu = (G == 256) ? ((((u >> 8) * 128 + (bid & 7) * 16 + (bid >> 4)) << 1) | ((bid >> 3) & 1)) : u;
            P.latent = 0; P.b = uu >> 5; P.h = (uu >> 1) & 15; P.nchunks = 4; rowbase = P.b * 256 + (uu & 1) * 128; }
        else { const int v0 = u - 512; const int v = (G == 256) ? ((((v0 >> 8) * 32 + (bid & 7) * 4 + (bid >> 6)) << 3) | ((bid >> 3) & 7)) : v0;
            P.latent = 1; P.b = v >> 7; P.h = (v >> 3) & 15; P.nchunks = 24; rowbase = NCTX + P.b * 1024 + (v & 7) * 128; }
        { const int rep = 1;
        const int row = rowbase + 32 * wq + r32;
        bf16x8 qr[4];
#pragma unroll
        for (int d0 = 0; d0 < 4; ++d0) qr[d0] = *(const bf16x8*)(QKV + (size_t)row * 6144 + P.h * 128 + j * 64 + 16 * d0 + 8 * h2);
        f32x16 o[4];
#pragma unroll
        for (int d0 = 0; d0 < 4; ++d0)
#pragma unroll
            for (int r = 0; r < 16; ++r) o[d0][r] = 0.f;
        float m = -1e30f, l = 0.f;
        asm volatile("s_waitcnt vmcnt(0)" ::: "memory");
#pragma unroll
        for (int d0 = 0; d0 < 4; ++d0) asm volatile("" : "+v"(qr[d0]));
        asm volatile("" : "+v"(m));
        if (rep == 1) attn_loop<64, 128, 128, PolA>(lds, P, qr, o, m, l, tid);
        const float inv = 1.0f / l;
        if (j == 1) {
#pragma unroll
            for (int d0 = 0; d0 < 4; ++d0)
#pragma unroll
                for (int r = 0; r < 16; ++r) xb[((wq * 4 + d0) * 16 + r) * 64 + lane] = o[d0][r] * inv;
        }
        __syncthreads();
        if (j == 0) {
            const float* lp = A.in[20];
            const float d1 = wave_sum(lp[(0 * 16 + P.h) * 64 + lane] * lp[(1 * 16 + P.h) * 64 + lane]);
            const float d2 = wave_sum(lp[(2 * 16 + P.h) * 64 + lane] * lp[(3 * 16 + P.h) * 64 + lane]);
            const float lam = __expf(d1) - __expf(d2) + lam_init;
            float ss = 0.f;
#pragma unroll
            for (int d0 = 0; d0 < 4; ++d0)
#pragma unroll
                for (int r = 0; r < 16; ++r) { const float v = o[d0][r] * inv - lam * xb[((wq * 4 + d0) * 16 + r) * 64 + lane]; o[d0][r] = v; ss += v * v; }
            ss = hsum(ss);
            const float rs = (1.0f / sqrtf(ss * (1.f / 128.f) + RMS_EPS)) * (1.0f - lam_init);
            const float* sub = A.in[21];
#pragma unroll
            for (int d0 = 0; d0 < 4; ++d0)
#pragma unroll
                for (int r = 0; r < 16; ++r) o[d0][r] *= sub[32 * d0 + crow(r, h2)];
            store_ot<4>(o, rs, O + (size_t)row * DM + P.h * 128, h2);
        }
        __syncthreads();
        }
    }
}

struct PolC {
    static constexpr float sc2 = 0.08838834764831845f * LOG2E;
    int nchunks, kcol; const bf16* QKV; const bf16* CK; const bf16* CV; int b, h, latent;
    int nb, krlo, r, r0, qc, cstart; const LAS float* rpb;
    DI void src(int c, const bf16*& kp, const bf16*& vp, size_t& st) const {
        if (latent && c >= nb) { const size_t off = ((size_t)(b * 512 + 64 * (c - nb)) * 16 + h) * 128; kp = CK + off; vp = CV + off; st = 2048; }
        else { const int row = latent ? NCTX + b * 1024 + 64 * (krlo + c) : b * 256 + 64 * c; kp = QKV + (size_t)row * 6144 + 2048 + h * 128; vp = kp + 2048; st = 6144; }
    }
    DI bool active(int c) const { return !latent || c >= nb || (krlo + c >= r0 && krlo + c < r0 + 8); }
    DI void fix(int c, int kt, f32x16& s) const {
        if (latent && c < nb) {
            int h2 = (threadIdx.x >> 5) & 1; asm volatile("" : "+v"(h2));
            const int kr = krlo + c;
            int drow = kr - r + 7; drow = drow < 0 ? 0 : (drow > 14 ? 14 : drow);
#pragma unroll
            for (int rr = 0; rr < 16; ++rr) { const int kc = 32 * kt + crow(rr, h2); const bool ok = (kc >= cstart) && (kc < cstart + 16);
                int dc = kc - qc + 15; dc = dc < 0 ? 0 : (dc > 30 ? 30 : dc);
                const float bias = rpb[drow * 31 + dc];
                s[rr] = ok ? s[rr] + bias : -INFINITY; }
        }
    }
};
DI void phaseC(const Args& A, ldsp lds, int G, int bid, int tid) {
    const int lane = tid & 63, wave = __builtin_amdgcn_readfirstlane(tid >> 6), r32 = lane & 31, h2 = lane >> 5;
    const bf16* QKV = (const bf16*)(A.ws + WS_QKV); bf16* O = (bf16*)(A.ws + WS_O);
    LAS float* rpbL = (LAS float*)(lds + 4 * 32768);
    for (int u = bid; u < 512; u += G) {
        PolC P; P.QKV = QKV; P.CK = (const bf16*)(A.ws + WS_CCK); P.CV = (const bf16*)(A.ws + WS_CCV); P.kcol = 0; P.rpb = rpbL;
        int row;
        if (u < 256) { P.latent = 0; P.b = u >> 4; P.h = u & 15; P.nchunks = 4; row = P.b * 256 + 32 * wave + r32; P.nb = 0; P.krlo = 0; P.r = 0; P.r0 = 0; P.qc = 0; P.cstart = 0; }
        else { const int v0 = u - 256; const int v = (G == 256) ? ((((bid & 7) * 8 + (bid >> 5)) << 2) | ((bid >> 3) & 3)) : v0;
            P.latent = 1; P.b = v >> 6; P.h = (v >> 2) & 15; const int R4 = v & 3;
            const int rlo = 4 * R4, rhi = 4 * R4 + 3;
            const int r0lo = rlo - 4 < 0 ? 0 : (rlo - 4 > 8 ? 8 : rlo - 4), r0hi = rhi - 4 < 0 ? 0 : (rhi - 4 > 8 ? 8 : rhi - 4);
            P.krlo = r0lo; P.nb = r0hi + 8 - r0lo; P.nchunks = P.nb + 8;
            P.r = rlo + (wave >> 1); P.r0 = P.r - 4 < 0 ? 0 : (P.r - 4 > 8 ? 8 : P.r - 4);
            P.qc = 32 * (wave & 1) + r32; P.cstart = P.qc - 8 < 0 ? 0 : (P.qc - 8 > 48 ? 48 : P.qc - 8);
            row = NCTX + P.b * 1024 + P.r * 64 + P.qc;
            for (int i = tid; i < 15 * 31; i += NTHR) rpbL[i] = A.in[28][(size_t)P.h * 465 + i] * 11.313708498984761f;
        }
        bf16x8 qr[8];
#pragma unroll
        for (int d0 = 0; d0 < 8; ++d0) qr[d0] = *(const bf16x8*)(QKV + (size_t)row * 6144 + P.h * 128 + 16 * d0 + 8 * h2);
        f32x16 o[4];
#pragma unroll
        for (int d0 = 0; d0 < 4; ++d0)
#pragma unroll
            for (int r = 0; r < 16; ++r) o[d0][r] = 0.f;
        float m = -1e30f, l = 0.f;
        asm volatile("s_waitcnt vmcnt(0)" ::: "memory");
#pragma unroll
        for (int d0 = 0; d0 < 8; ++d0) asm volatile("" : "+v"(qr[d0]));
        asm volatile("" : "+v"(m));
        attn_loop<128, 128, 128, PolC>(lds, P, qr, o, m, l, tid);
        store_ot<4>(o, 1.0f / l, O + (size_t)row * DM + P.h * 128, h2);
    }
}

struct PolD {
    static constexpr float sc2 = 0.125f * LOG2E;
    int nchunks, kcol; const bf16* QKV; const bf16* CK; const bf16* CV; int b, kvh, latent;
    int nl, kc0, qpos;
    DI void src(int c, const bf16*& kp, const bf16*& vp, size_t& st) const {
        if (latent && c >= nl) { const size_t off = ((size_t)(b * 512 + 64 * (c - nl)) * 8 + kvh) * 64; kp = CK + off; vp = CV + off; st = 512; }
        else { const int row = latent ? NCTX + b * 1024 + 64 * (kc0 + c) : b * 256 + 64 * c; kp = QKV + (size_t)row * 3072 + 2048 + kvh * 64; vp = kp + 512; st = 3072; }
    }
    DI bool active(int) const { return true; }
    DI void fix(int c, int kt, f32x16& s) const {
        if (latent && c < nl) {
            int h2 = (threadIdx.x >> 5) & 1; asm volatile("" : "+v"(h2));
#pragma unroll
            for (int rr = 0; rr < 16; ++rr) { const int kpos = 64 * (kc0 + c) + 32 * kt + crow(rr, h2); const int d = qpos - kpos;
                s[rr] = (d <= 128 && d >= -128) ? s[rr] : -INFINITY; }
        }
    }
};
DI void phaseD(const Args& A, ldsp lds, int G, int bid, int tid) {
    const int lane = tid & 63, wave = tid >> 6, r32 = lane & 31, h2 = lane >> 5, g = wave >> 1, qsub = wave & 1;
    const bf16* QKV = (const bf16*)(A.ws + WS_QKV); bf16* O = (bf16*)(A.ws + WS_O);
    for (int u = bid; u < 1024; u += G) {
        PolD P; P.QKV = QKV; P.CK = (const bf16*)(A.ws + WS_CDK); P.CV = (const bf16*)(A.ws + WS_CDV); P.kcol = 0;
        int row;
        if (u < 512) { const int uu = (G == 256) ? ((((u >> 8) * 64 + (bid & 7) * 8 + (bid >> 5)) << 2) | ((bid >> 3) & 3)) : u;
            P.latent = 0; P.b = uu >> 5; P.kvh = (uu >> 2) & 7; P.nchunks = 4; P.nl = 0; P.kc0 = 0; P.qpos = 0; row = P.b * 256 + 64 * (uu & 3) + 32 * qsub + r32; }
        else { const int v0 = u - 512; const int v = (G == 256) ? ((((v0 >> 8) * 16 + (bid & 7) * 2 + (bid >> 7)) << 4) | ((bid >> 3) & 15)) : v0;
            P.latent = 1; P.b = v >> 7; P.kvh = (v >> 4) & 7; const int qb = v & 15;
            P.kc0 = qb - 2 < 0 ? 0 : qb - 2; const int kc1 = qb + 3 > 15 ? 15 : qb + 3; P.nl = kc1 - P.kc0 + 1; P.nchunks = P.nl + 8;
            P.qpos = 64 * qb + 32 * qsub + r32; row = NCTX + P.b * 1024 + P.qpos; }
        bf16x8 qr[4];
#pragma unroll
        for (int d0 = 0; d0 < 4; ++d0) qr[d0] = *(const bf16x8*)(QKV + (size_t)row * 3072 + P.kvh * 256 + g * 64 + 16 * d0 + 8 * h2);
        f32x16 o[2];
#pragma unroll
        for (int d0 = 0; d0 < 2; ++d0)
#pragma unroll
            for (int r = 0; r < 16; ++r) o[d0][r] = 0.f;
        float m = A.in[31][P.kvh * 4 + g] * LOG2E, l = 1.0f;
        asm volatile("s_waitcnt vmcnt(0)" ::: "memory");
#pragma unroll
        for (int d0 = 0; d0 < 4; ++d0) asm volatile("" : "+v"(qr[d0]));
        asm volatile("" : "+v"(m));
        attn_loop<64, 64, 64, PolD>(lds, P, qr, o, m, l, tid);
        store_ot<2>(o, 1.0f / l, O + (size_t)row * DM + P.kvh * 256 + g * 64, h2);
    }
}

DI float logsigmoid(float x) { return fminf(x, 0.f) - log1pf(expf(-fabsf(x))); }
DI void mlstm_scan(const float* gates, int rowbase, int h, int dir, float m0, int T, LAS float* At, LAS float* Mt, LAS float* Gt, int lane) {
    float cG = 0.f, cM = m0;
#pragma unroll 1
    for (int seg = 0; seg < T; seg += 256) {
        float gi[4], gf[4];
#pragma unroll
        for (int e = 0; e < 4; ++e) { const int p = seg + lane * 4 + e, t = dir ? T - 1 - p : p; const float* gr = gates + (size_t)(rowbase + t) * 32 + dir * 16 + h;
            gi[e] = gr[0]; gf[e] = logsigmoid(gr[8]); }
        float run = 0.f;
#pragma unroll
        for (int e = 0; e < 4; ++e) { run += gf[e]; gf[e] = run; }
        float pre = run;
#pragma unroll
        for (int o = 1; o < 64; o <<= 1) { const float v = __shfl_up(pre, o); if (lane >= o) pre += v; }
        const float tot = __shfl(pre, 63);
        pre = pre - run + cG;
        float mx = -INFINITY;
#pragma unroll
        for (int e = 0; e < 4; ++e) { gf[e] += pre; gi[e] -= gf[e]; mx = fmaxf(mx, gi[e]); }
        float pm = mx;
#pragma unroll
        for (int o = 1; o < 64; o <<= 1) { const float v = __shfl_up(pm, o); if (lane >= o) pm = fmaxf(pm, v); }
        const float allm = __shfl(pm, 63);
        float ex = __shfl_up(pm, 1); if (lane == 0) ex = -INFINITY;
        float rm = fmaxf(cM, ex);
#pragma unroll
        for (int e = 0; e < 4; ++e) { const int p = seg + lane * 4 + e, t = dir ? T - 1 - p : p; rm = fmaxf(rm, gi[e]); At[t] = gi[e]; Mt[t] = rm; Gt[t] = gf[e]; }
        cG += tot; cM = fmaxf(cM, allm);
    }
}

constexpr int B_PKB = 272, B_PVB = 576, B_KBYTES = 64 * B_PKB, B_VBYTES = 64 * B_PVB, B_BUF = B_KBYTES + B_VBYTES;
constexpr int BR_K = 16384, BR_V = 32768, BR_STG = BR_K + BR_V, BR_NS = 3;
constexpr int BL_ET = BR_NS * BR_STG;
constexpr int BL_RC = BL_ET + 8192;
constexpr int BL_AD = BL_RC + 128;
constexpr int BL_MG = BL_AD + 512;
constexpr int BL_SX = BL_MG + 1024;
static_assert(BL_SX + 2048 <= LDS_PHASE_BYTES, "phase B LDS map");

template <int EL> DI void mlstm_scan8(const float* gates, int rowbase, int h, int T, int qb, float m0, ldsp lds, int wave, int lane) {
    const int dir = wave >> 2, sg = wave & 3, SL = 64 * EL;
    LAS float* Et = (LAS float*)(lds + BL_ET) + dir * 1024; LAS float* Rc = (LAS float*)(lds + BL_RC) + dir * 16; LAS float* Ad = (LAS float*)(lds + BL_AD) + dir * 64;
    LAS float* MG = (LAS float*)(lds + BL_MG) + dir * 128; LAS float* sx = (LAS float*)(lds + BL_SX);
    float gi[EL], gf[EL], pmx[EL];
#pragma unroll
    for (int e = 0; e < EL; ++e) { const int p = sg * SL + lane * EL + e, t = dir ? T - 1 - p : p; const float* gr = gates + (size_t)(rowbase + t) * 32 + dir * 16 + h;
        gi[e] = gr[0]; gf[e] = logsigmoid(gr[8]); }
    float run = 0.f;
#pragma unroll
    for (int e = 0; e < EL; ++e) { run += gf[e]; gf[e] = run; }
    float pre = run;
#pragma unroll
    for (int o = 1; o < 64; o <<= 1) { const float v = __shfl_up(pre, o); if (lane >= o) pre += v; }
    const float tot = __shfl(pre, 63);
    pre -= run;
    float mx = -INFINITY;
#pragma unroll
    for (int e = 0; e < EL; ++e) { gf[e] += pre; gi[e] -= gf[e]; mx = fmaxf(mx, gi[e]); pmx[e] = mx; }
    float pm = mx;
#pragma unroll
    for (int o = 1; o < 64; o <<= 1) { const float v = __shfl_up(pm, o); if (lane >= o) pm = fmaxf(pm, v); }
    const float allm = __shfl(pm, 63);
    float ex = __shfl_up(pm, 1); if (lane == 0) ex = -INFINITY;
    if (lane == 0) { sx[wave * 2] = tot; sx[wave * 2 + 1] = allm; }
    __syncthreads();
    float cG = 0.f, cM = m0;
    for (int s2 = 0; s2 < sg; ++s2) { cM = fmaxf(cM, sx[(dir * 4 + s2) * 2 + 1] - cG); cG += sx[(dir * 4 + s2) * 2]; }
    float cm = mx;
#pragma unroll
    for (int o = 1; o < 64 / EL; o <<= 1) cm = fmaxf(cm, __shfl_xor(cm, o));
    cm -= cG;
    const int p0 = sg * SL + lane * EL, t0 = dir ? T - 1 - p0 : p0, ch = t0 >> 6;
    if ((lane & (64 / EL - 1)) == 0) Rc[ch] = cm;
#pragma unroll
    for (int e = 0; e < EL; ++e) { const int p = p0 + e, t = dir ? T - 1 - p : p;
        const float a = gi[e] - cG, Gv = gf[e] + cG, Mv = fmaxf(fmaxf(cM, ex - cG), pmx[e] - cG);
        Et[t] = ex2((a - cm) * LOG2E);
        if (ch == qb) { Ad[t & 63] = a; MG[(t & 63) * 2] = Mv; MG[(t & 63) * 2 + 1] = Gv; } }
}

DI void phaseB(const Args& A, ldsp lds, int G, int bid, int tid) {
    const int lane = tid & 63, wave = __builtin_amdgcn_readfirstlane(tid >> 6), r32 = lane & 31, h2 = lane >> 5, i16 = lane & 15, tq = i16 >> 2, tp = i16 & 3, blk = (lane >> 4) & 1;
    const int qsub = wave & 1, dvh = (wave >> 1) & 1, dir = wave >> 2;
    const bf16* QKV = (const bf16*)(A.ws + WS_QKV); bf16* O = (bf16*)(A.ws + WS_O); const float* gates = (const float*)(A.ws + WS_GATES);
    LAS float* At = (LAS float*)(lds + BL_ET); LAS float* Mt = At + 256; LAS float* Gt = Mt + 256;
    LAS float* sx = (LAS float*)(lds + BL_SX);
    LAS float* xb = (LAS float*)lds;
    const float scale = 0.08838834764831845f;
    const int kx = r32 & 15, krow = r32 * 256;
    const int vbase = (4 * h2 + tq) * 512 + 32 * blk + 8 * tp;
    for (int u = bid; u < 1024; u += G) {
        int latent, b, h, qb, T, rowbase;
        if (u < 512) { const int uu = (G == 256) ? ((((u >> 8) * 64 + (bid & 7) * 8 + (bid >> 5)) << 2) | ((bid >> 3) & 3)) : u;
            latent = 0; b = uu >> 5; h = (uu >> 2) & 7; qb = uu & 3; T = 256; rowbase = b * 256; }
        else { const int v0 = u - 512; const int v = (G == 256) ? ((((v0 >> 8) * 16 + (bid & 7) * 2 + (bid >> 7)) << 4) | ((bid >> 3) & 15)) : v0;
            latent = 1; b = v >> 7; h = (v >> 4) & 7; qb = v & 15; T = 1024; rowbase = NCTX + b * 1024; }
        const int nch = T / 64;
        { const float m0s = latent ? A.in[6][(b * 2 + dir) * 8 + h] : 0.f;
          if (latent) mlstm_scan8<4>(gates, rowbase, h, T, qb, m0s, lds, wave, lane); else mlstm_scan8<1>(gates, rowbase, h, T, qb, m0s, lds, wave, lane); }
        __syncthreads();
        const int t = 64 * qb + 32 * qsub + r32, row = rowbase + t;
        const float Mq = ((LAS float*)(lds + BL_MG))[dir * 128 + (32 * qsub + r32) * 2], Gq = ((LAS float*)(lds + BL_MG))[dir * 128 + (32 * qsub + r32) * 2 + 1];
        const LAS float* Et = (const LAS float*)(lds + BL_ET) + dir * 1024; const LAS float* Rc = (const LAS float*)(lds + BL_RC) + dir * 16; const LAS float* Ad = (const LAS float*)(lds + BL_AD) + dir * 64;
        bf16x8 qr[8];
#pragma unroll
        for (int d0 = 0; d0 < 8; ++d0) qr[d0] = *(const bf16x8*)(QKV + (size_t)row * 6144 + h * 128 + 16 * d0 + 8 * h2);
        f32x16 o[4];
#pragma unroll
        for (int d0 = 0; d0 < 4; ++d0)
#pragma unroll
            for (int r = 0; r < 16; ++r) o[d0][r] = 0.f;
        float den = 0.f;
        const bf16* kp0 = QKV + (size_t)rowbase * 6144 + 1024 + h * 128; const bf16* vp0 = QKV + (size_t)rowbase * 6144 + 2048 + h * 256;
        asm volatile("s_waitcnt vmcnt(0) lgkmcnt(0)" ::: "memory");
#pragma unroll
        for (int d0 = 0; d0 < 8; ++d0) asm volatile("" : "+v"(qr[d0]));
#ifdef DUP_BLOOP
        for (int rep = 0; rep < 2; ++rep) {
#pragma unroll
        for (int d0 = 0; d0 < 4; ++d0)
#pragma unroll
            for (int r = 0; r < 16; ++r) o[d0][r] = 0.f;
        den = 0.f;
#endif
#pragma unroll
        for (int k = 0; k < 2; ++k) { ldsp sb = lds + k * BR_STG; dma_tile<256, false>(sb, kp0 + (size_t)(64 * k) * 6144, 6144, wave, lane); dma_tile<512, true>(sb + BR_K, vp0 + (size_t)(64 * k) * 6144, 6144, wave, lane); }
        for (int c = 0; c < nch; ++c) {
            if (c + 1 < nch) VM_WAIT_N(6); else VM_WAIT_N(0);
            __builtin_amdgcn_s_barrier(); asm volatile("" ::: "memory");
            if (c + 2 < nch) { const int stg = (c + 2) % BR_NS; ldsp sb = lds + stg * BR_STG; dma_tile<256, false>(sb, kp0 + (size_t)(64 * (c + 2)) * 6144, 6144, wave, lane); dma_tile<512, true>(sb + BR_K, vp0 + (size_t)(64 * (c + 2)) * 6144, 6144, wave, lane); }
            ldsp kb = lds + (c % BR_NS) * BR_STG; ldsp vb = kb + BR_K;
            const bool act = dir ? (c >= qb) : (c <= qb);
            if (act) {
                const bool diag = (c == qb);
                const float fc = ex2((Rc[c] - Mq) * LOG2E) * scale;
#pragma unroll
                for (int kt = 0; kt < 2; ++kt) {
                    const bool tact = !(diag && (dir ? kt < qsub : kt > qsub));
                    if (tact) {
                        f32x16 s;
#pragma unroll
                        for (int i = 0; i < 16; ++i) s[i] = 0.f;
#pragma unroll
                        for (int d0 = 0; d0 < 8; ++d0) { const bf16x8 a = *(const LAS bf16x8*)(kb + 32 * kt * 256 + krow + (((h2 + 2 * d0) ^ kx) << 4)); s = MFMA32(a, qr[d0], s); }
                        int h2l = h2; asm volatile("" : "+v"(h2l));
                        if (!diag) {
#pragma unroll
                            for (int g = 0; g < 4; ++g) { const f32x4 e4 = *(const LAS f32x4*)(Et + 64 * c + 32 * kt + 8 * g + 4 * h2l);
#pragma unroll
                                for (int j = 0; j < 4; ++j) { const float p = s[4 * g + j] * (e4[j] * fc); s[4 * g + j] = p; den += p; } }
                        } else {
#pragma unroll
                            for (int g = 0; g < 4; ++g) { const f32x4 a4 = *(const LAS f32x4*)(Ad + 32 * kt + 8 * g + 4 * h2l);
#pragma unroll
                                for (int j = 0; j < 4; ++j) { const int si = 64 * c + 32 * kt + 8 * g + 4 * h2l + j; const float w = ex2((a4[j] - Mq) * LOG2E);
                                    const bool ok = dir ? si >= t : si <= t; const float p = ok ? s[4 * g + j] * scale * w : 0.f; s[4 * g + j] = p; den += p; } }
                        }
                        const bf16x8 p0 = pack8<0>(s), p1 = pack8<1>(s);
                        const unsigned va0 = (unsigned)(__UINTPTR_TYPE__)vb + (unsigned)((32 * kt) * 512 + vbase);
#pragma unroll
                        for (int dp = 0; dp < 2; ++dp) {
                            const unsigned a = va0 + 64 * ((4 * dvh + 2 * dp) ^ tq), bq = va0 + 64 * ((4 * dvh + 2 * dp + 1) ^ tq);
                            const s16x4 l0 = tr_asm<0>(a), h0 = tr_asm<8 * 512>(a), l1 = tr_asm<16 * 512>(a), h1 = tr_asm<24 * 512>(a);
                            const s16x4 m0 = tr_asm<0>(bq), n0 = tr_asm<8 * 512>(bq), m1 = tr_asm<16 * 512>(bq), n1 = tr_asm<24 * 512>(bq);
                            asm volatile("s_waitcnt lgkmcnt(0)" ::: "memory"); __builtin_amdgcn_sched_barrier(0);
                            const bf16x8 a0 = {l0[0], l0[1], l0[2], l0[3], h0[0], h0[1], h0[2], h0[3]};
                            const bf16x8 a1 = {l1[0], l1[1], l1[2], l1[3], h1[0], h1[1], h1[2], h1[3]};
                            const bf16x8 b0 = {m0[0], m0[1], m0[2], m0[3], n0[0], n0[1], n0[2], n0[3]};
                            const bf16x8 b1 = {m1[0], m1[1], m1[2], m1[3], n1[0], n1[1], n1[2], n1[3]};
                            o[2 * dp] = MFMA32(a0, p0, o[2 * dp]);
                            o[2 * dp + 1] = MFMA32(b0, p0, o[2 * dp + 1]);
                            o[2 * dp] = MFMA32(a1, p1, o[2 * dp]);
                            o[2 * dp + 1] = MFMA32(b1, p1, o[2 * dp + 1]);
                        }
                    }
                }
            }
        }
        asm volatile("s_waitcnt lgkmcnt(0)" ::: "memory"); __builtin_amdgcn_s_barrier(); asm volatile("" ::: "memory");
#ifdef DUP_BLOOP
        }
#endif
        den = hsum(den);
#ifndef NO_BSTATE
        if (latent) {
            const float m0 = A.in[6][(b * 2 + dir) * 8 + h];
            const float coef = ex2((m0 - Mq) * LOG2E) * scale;
            const bf16* SC = (const bf16*)(A.ws + WS_SC) + ((size_t)((b * 2 + dir) * 8 + h) * 256 + dvh * 128 + r32) * 128 + 8 * h2;
#pragma unroll
            for (int d0 = 0; d0 < 4; ++d0) { f32x16 tmp;
#pragma unroll
                for (int r = 0; r < 16; ++r) tmp[r] = 0.f;
#pragma unroll
                for (int ds = 0; ds < 8; ++ds) { const bf16x8 a = *(const bf16x8*)(SC + (size_t)d0 * 32 * 128 + 16 * ds); tmp = MFMA32(a, qr[ds], tmp); }
#pragma unroll
                for (int r = 0; r < 16; ++r) o[d0][r] += coef * tmp[r]; }
            const float* n0 = A.in[5] + ((b * 2 + dir) * 8 + h) * 128 + 8 * h2;
            float dot = 0.f;
#pragma unroll
            for (int ds = 0; ds < 8; ++ds)
#pragma unroll
                for (int jj = 0; jj < 8; ++jj) dot += bf2f((unsigned short)qr[ds][jj]) * n0[16 * ds + jj];
            dot = hsum(dot);
            den += coef * dot;
        }
#endif
        const float hinv = 1.0f / fmaxf(fabsf(den), __expf(-(Gq + Mq)));
        if (dir == 1) {
#pragma unroll
            for (int d0 = 0; d0 < 4; ++d0)
#pragma unroll
                for (int r = 0; r < 16; ++r) xb[(((wave & 3) * 4 + d0) * 16 + r) * 64 + lane] = o[d0][r] * hinv;
        }
        __syncthreads();
        float ss = 0.f;
        if (dir == 0) {
#pragma unroll
            for (int d0 = 0; d0 < 4; ++d0)
#pragma unroll
                for (int r = 0; r < 16; ++r) { const float v = o[d0][r] * hinv + xb[((wave * 4 + d0) * 16 + r) * 64 + lane]; o[d0][r] = v; ss += v * v; }
            ss = hsum(ss);
            if (h2 == 0) sx[wave * 32 + r32] = ss;
        }
        __syncthreads();
        if (dir == 0) {
            const float tot = ss + sx[(wave ^ 2) * 32 + r32];
            const float rs = 1.0f / sqrtf(tot * (1.f / 256.f) + RMS_EPS);
            const float* nw = A.in[25] + h * 256 + dvh * 128; const bf16* og = QKV + (size_t)row * 6144 + 4096 + h * 256 + dvh * 128;
#pragma unroll
            for (int d0 = 0; d0 < 4; ++d0)
#pragma unroll
                for (int g = 0; g < 4; ++g) { const int dv = 32 * d0 + 8 * g + 4 * h2;
                    const u32x2 ow = *(const u32x2*)(og + dv); const f32x4 nv = *(const f32x4*)(nw + dv);
                    const float g0 = 1.f / (1.f + __expf(-bflo(ow.x))), g1 = 1.f / (1.f + __expf(-bfhi(ow.x))), g2 = 1.f / (1.f + __expf(-bflo(ow.y))), g3 = 1.f / (1.f + __expf(-bfhi(ow.y)));
                    u32x2 w; w.x = pk2(o[d0][4 * g] * rs * nv[0] * g0, o[d0][4 * g + 1] * rs * nv[1] * g1); w.y = pk2(o[d0][4 * g + 2] * rs * nv[2] * g2, o[d0][4 * g + 3] * rs * nv[3] * g3);
                    *(u32x2*)(O + (size_t)row * DM + h * 256 + dvh * 128 + dv) = w; }
        }
        __syncthreads();
    }
    LAS float* Wt = sx + 256;
#ifndef NO_BFINAL
    for (int u = bid; u < 256; u += G) {
        const int b = u >> 4, h = (u >> 1) & 7, sd = u & 1, rowbase = b * 256;
        if (wave == 0) mlstm_scan(gates, rowbase, h, sd, 0.f, 256, At, Mt, Gt, lane);
        __syncthreads();
        const int tl = sd ? 0 : 255;
        const float MT = Mt[tl], GT = Gt[tl];
        if (tid < 256) Wt[tid] = ex2((At[tid] - MT) * LOG2E);
        __syncthreads();
        f32x16 acc[4];
#pragma unroll
        for (int nt = 0; nt < 4; ++nt)
#pragma unroll
            for (int r = 0; r < 16; ++r) acc[nt][r] = 0.f;
        float nacc = 0.f;
        const int aoff = (8 * h2 + tq) * B_PVB + (32 * wave + 16 * blk + 4 * tp) * 2;
        const int boff = (8 * h2 + tq) * B_PKB + (16 * blk + 4 * tp) * 2;
        bf16x8 kst[2], vst[4];
        { const bf16* kp = QKV + (size_t)rowbase * 6144 + 1024 + h * 128; const bf16* vp = QKV + (size_t)rowbase * 6144 + 2048 + h * 256;
          stage_ld<128>(kst, kp, 6144, tid); stage_ld<256>(vst, vp, 6144, tid); }
        for (int c = 0; c < 4; ++c) {
            ldsp kb = lds + (c & 1) * B_BUF; ldsp vb = kb + B_KBYTES;
#pragma unroll
            for (int i = 0; i < 4; ++i) { const int idx = tid + NTHR * i, rw = idx / 32; const float w = Wt[64 * c + rw];
                const u32x4 x = __builtin_bit_cast(u32x4, vst[i]); u32x4 y;
                y.x = pk2(bflo(x.x) * w, bfhi(x.x) * w); y.y = pk2(bflo(x.y) * w, bfhi(x.y) * w); y.z = pk2(bflo(x.z) * w, bfhi(x.z) * w); y.w = pk2(bflo(x.w) * w, bfhi(x.w) * w);
                vst[i] = __builtin_bit_cast(bf16x8, y); }
            stage_st<128>(kst, kb, B_PKB, tid); stage_st<256>(vst, vb, B_PVB, tid);
            __syncthreads();
            if (c + 1 < 4) { const bf16* kp = QKV + (size_t)(rowbase + 64 * (c + 1)) * 6144 + 1024 + h * 128; const bf16* vp = QKV + (size_t)(rowbase + 64 * (c + 1)) * 6144 + 2048 + h * 256;
                stage_ld<128>(kst, kp, 6144, tid); stage_ld<256>(vst, vp, 6144, tid); }
#pragma unroll
            for (int ks = 0; ks < 4; ++ks) {
                const s16x4 al = tr_read(vb + aoff + 16 * ks * B_PVB), ah = tr_read(vb + aoff + (16 * ks + 4) * B_PVB);
                const bf16x8 a = {al[0], al[1], al[2], al[3], ah[0], ah[1], ah[2], ah[3]};
#pragma unroll
                for (int nt = 0; nt < 4; ++nt) {
                    const s16x4 bl = tr_read(kb + boff + 16 * ks * B_PKB + 64 * nt), bh = tr_read(kb + boff + (16 * ks + 4) * B_PKB + 64 * nt);
                    const bf16x8 bb = {bl[0], bl[1], bl[2], bl[3], bh[0], bh[1], bh[2], bh[3]};
                    acc[nt] = MFMA32(a, bb, acc[nt]);
                }
            }
            if (tid < 128) {
#pragma unroll 8
                for (int s = 0; s < 64; ++s) nacc += Wt[64 * c + s] * bf2f(*(const LAS unsigned short*)(kb + s * B_PKB + tid * 2));
            }
        }
        float* oc = A.out + O_BC + ((size_t)((b * 2 + sd) * 8 + h) * 256) * 128;
#pragma unroll
        for (int nt = 0; nt < 4; ++nt)
#pragma unroll
            for (int r = 0; r < 16; ++r) oc[(size_t)(32 * wave + crow(r, h2)) * 128 + 32 * nt + r32] = acc[nt][r];
        if (tid < 128) A.out[O_BN + ((b * 2 + sd) * 8 + h) * 128 + tid] = nacc;
        if (tid == 0) A.out[O_BM + (b * 2 + sd) * 8 + h] = GT + MT;
        __syncthreads();
    }
#endif
}

constexpr int N_PHASES = 3 + 7 * NLAYER;
#define PH(b) ((MASK >> (b)) & 1)
#ifndef DUPMASK
#define DUPMASK 0
#endif
#define DUP(b) (((DUPMASK >> (b)) & 1) ? 2 : 1)
template <int MASK> __global__ void __launch_bounds__(NTHR, 2) fwd_kernel(Args args) {
    extern __shared__ __attribute__((aligned(16))) unsigned char lds_raw[];
    ldsp lds = (ldsp)lds_raw;
    const int tid0 = threadIdx.x, bid = blockIdx.x, G = gridDim.x;
#define TIDL() ({ int t_ = threadIdx.x; asm volatile("" : "+v"(t_)); t_; })
    const int tid = tid0;
    volatile LAS unsigned* MISC = (volatile LAS unsigned*)(lds + MISC_OFF);
    for (int u = tid; u < 64; u += NTHR) MISC[u] = 0u;
    __syncthreads();
    const int lo = args.ph_lo, hi = args.ph_hi;
    unsigned* ctl = (unsigned*)(args.ws + WS_CTL);
    XcdBarrier bar; bar.bar = ctl + CW_BAR; bar.x = 0; bar.st = nullptr;
    const bool multi = (hi - lo) > 1;
    if (multi) bar = xcd_barrier_post(ctl + CW_BAR, MISC + 8);
#define IN(k) (lo <= (k) && (k) < hi)
#define SEAM(k) do { if (IN(k) && IN((k) + 1)) xcd_barrier(bar); } while (0)
    unsigned char* ws = args.ws;
    bf16* Hb = (bf16*)(ws + WS_H); bf16* QKVb = (bf16*)(ws + WS_QKV); bf16* Ob = (bf16*)(ws + WS_O); bf16* Yb = (bf16*)(ws + WS_Y); bf16* Ub = (bf16*)(ws + WS_U);

    if (DUP(12) == 2 && multi) { for (int rep = 0; rep < 32; ++rep) xcd_barrier(bar); }
    if (PH(0) && IN(0)) { for (int rep = 0; rep < DUP(0); ++rep) { p0a_prologue(args, lds, G, bid, TIDL()); __syncthreads(); } } SEAM(0);
    if (PH(1) && IN(1)) { p0b_modreduce(args, G, bid, TIDL()); } SEAM(1);
    if (PH(2) && IN(2)) { RowP P; P.Y = nullptr; P.mod_gate = 0; P.Lg = 0; P.gpost = 0; P.has_next = 1; P.Ln = 0; P.gpre = 0; P.mod_shift = 0; P.do_gates = 0; P.dry = 0; row_phase(args, P, lds, G, bid, TIDL()); } SEAM(2);

    for (int L = 0; L < NLAYER; ++L) {
        const int base = 3 + 7 * L;
        if (PH(3) && IN(base)) {
            pg8::EpiInProj E; E.O = QKVb; E.rtab = (const LAS float*)(lds + pg8::STAGE_BYTES);
            if (L == 0 || L == 3) { const int t_ = TIDL(); for (int i = t_; i < 2048; i += NTHR) ((LAS float*)(lds + pg8::STAGE_BYTES))[i] = ((const float*)(ws + WS_ROPE))[i]; __syncthreads(); }
            const bf16* Wt; int N;
            if (L == 0)      { Wt = (const bf16*)(ws + W_AIN); N = 6144; E.ck = args.out + O_AK; E.cv = args.out + O_AV; E.kc0 = 2048; E.vc0 = 4096; E.kw = 2048; E.rope_cols = 4096; }
            else if (L == 1) { Wt = (const bf16*)(ws + W_BIN); N = 6144; E.ck = nullptr; E.cv = nullptr; E.kc0 = 0; E.vc0 = 0; E.kw = 0; E.rope_cols = 0; }
            else if (L == 2) { Wt = (const bf16*)(ws + W_CIN); N = 6144; E.ck = args.out + O_CK; E.cv = args.out + O_CV; E.kc0 = 2048; E.vc0 = 4096; E.kw = 2048; E.rope_cols = 0; }
            else             { Wt = (const bf16*)(ws + W_DIN); N = 3072; E.ck = args.out + O_DK; E.cv = args.out + O_DV; E.kc0 = 2048; E.vc0 = 2560; E.kw = 512; E.rope_cols = 2560; }
            E.ldc = N;
            pg8::Gemm g{Hb, Wt, NTOK, N, DM}; pg8::StaticOrder S; S.init(NTOK, N, G, bid);
            for (int rep = 0; rep < DUP(3); ++rep) { pg8::gemm_phase<pg8::EpiInProj, pg8::StaticOrder, false, true>((LAS unsigned char*)lds, g, S, E); __syncthreads(); }
        }
        SEAM(base);
        if (IN(base + 1)) { for (int rep = 0; rep < DUP(4 + L); ++rep) {
            if (PH(4) && L == 0) phaseA(args, lds, G, bid, TIDL());
            if (PH(5) && L == 1) phaseB(args, lds, G, bid, TIDL());
            if (PH(6) && L == 2) phaseC(args, lds, G, bid, TIDL());
            if (PH(7) && L == 3) phaseD(args, lds, G, bid, TIDL());
        } }
        SEAM(base + 1);
        if (PH(8) && IN(base + 2)) {
            const size_t wo = L == 0 ? W_AOUT : (L == 1 ? W_BOUT : (L == 2 ? W_COUT : W_DOUT));
            pg8::Gemm g{Ob, (const bf16*)(ws + wo), NTOK, DM, DM}; pg8::StaticOrder S; S.init(NTOK, DM, G, bid);
            pg8::EpiBf16<false> E{Yb, DM};
            for (int rep = 0; rep < DUP(8); ++rep) { pg8::gemm_phase<pg8::EpiBf16<false>, pg8::StaticOrder, true, true>((LAS unsigned char*)lds, g, S, E); __syncthreads(); }
        }
        SEAM(base + 2);
        if (PH(2) && IN(base + 3)) { RowP P; P.Y = Yb; P.mod_gate = 2; P.Lg = L; P.gpost = L * 4 + 1; P.has_next = 1; P.Ln = L; P.gpre = L * 4 + 2; P.mod_shift = 3; P.do_gates = 0; P.dry = 1; if (DUP(2) == 2) { row_phase(args, P, lds, G, bid, TIDL()); __syncthreads(); } P.dry = 0; row_phase(args, P, lds, G, bid, TIDL()); }
        SEAM(base + 3);
        if (PH(9) && IN(base + 4)) {
            pg8::Gemm g{Hb, (const bf16*)(ws + W_FF1) + (size_t)L * DM * DFF, NTOK, DFF, DM}; pg8::StaticOrder S; S.init(NTOK, DFF, G, bid);
            pg8::EpiBf16<true> E{Ub, DFF};
            for (int rep = 0; rep < DUP(9); ++rep) { pg8::gemm_phase<pg8::EpiBf16<true>, pg8::StaticOrder, false, true>((LAS unsigned char*)lds, g, S, E); __syncthreads(); }
        }
        SEAM(base + 4);
        if (PH(10) && IN(base + 5)) {
            pg8::Gemm g{Ub, (const bf16*)(ws + W_FF2) + (size_t)L * DM * DFF, NTOK, DM, DFF}; pg8::StaticOrder S; S.init(NTOK, DM, G, bid);
            pg8::EpiBf16<false> E{Yb, DM};
            for (int rep = 0; rep < DUP(10); ++rep) { pg8::gemm_phase<pg8::EpiBf16<false>, pg8::StaticOrder, true, true>((LAS unsigned char*)lds, g, S, E); __syncthreads(); }
        }
        SEAM(base + 5);
        if (PH(2) && IN(base + 6)) { RowP P; P.Y = Yb; P.mod_gate = 5; P.Lg = L; P.gpost = L * 4 + 3; P.has_next = (L + 1 < NLAYER); P.Ln = L + 1; P.gpre = (L + 1) * 4; P.mod_shift = 0; P.do_gates = (L + 1 == 1); P.dry = 1; if (DUP(2) == 2) { row_phase(args, P, lds, G, bid, TIDL()); __syncthreads(); } P.dry = 0; row_phase(args, P, lds, G, bid, TIDL()); }
        SEAM(base + 6);
    }
#undef IN
#undef SEAM
}

#ifndef FULLMASK
#define FULLMASK 0xFFFF
#endif
#ifndef MK_PER_PHASE
#define MK_PER_PHASE 0
#endif
template <int MASK> static int setup_kernel() {
    if (hipFuncSetAttribute((const void*)fwd_kernel<MASK>, hipFuncAttributeMaxDynamicSharedMemorySize, LDS_BYTES) != hipSuccess) { fprintf(stderr, "kernel_launch: hipFuncSetAttribute failed (mask %x)\n", MASK); return -1; }
    return 0;
}
template <int MASK> static void launch_range(const Args& a, int grid, hipStream_t stream) { hipLaunchKernelGGL(fwd_kernel<MASK>, dim3(grid), dim3(NTHR), LDS_BYTES, stream, a); }
extern "C" void kernel_launch(void* const* d_in, const int* in_sizes, int n_in, void* d_out, int out_size, void* d_ws, size_t ws_size, hipStream_t stream) {
    static int grid = 0;
    if (grid == 0) {
        if (n_in != 32 || out_size != (int)O_END || ws_size < WS_END) { fprintf(stderr, "kernel_launch: unexpected shapes: n_in %d out %d ws %zu (need %zu)\n", n_in, out_size, ws_size, (size_t)WS_END); grid = -1; return; }
        int dev = 0, cus = 0;
        if (hipGetDevice(&dev) != hipSuccess || hipDeviceGetAttribute(&cus, hipDeviceAttributeMultiprocessorCount, dev) != hipSuccess) { grid = -1; return; }
#if MK_PER_PHASE
        if (setup_kernel<1>() || setup_kernel<2>() || setup_kernel<4>() || setup_kernel<8>() || setup_kernel<16>() || setup_kernel<32>() || setup_kernel<64>() || setup_kernel<128>() || setup_kernel<256>() || setup_kernel<512>() || setup_kernel<1024>()) { grid = -1; return; }
#else
        if (setup_kernel<FULLMASK>()) { grid = -1; return; }
#endif
        (void)hipGetLastError();
        grid = cus;
    }
    if (grid < 0) return;
    (void)hipMemsetAsync((char*)d_ws + WS_CTL, 0, (CW_BAR + XCD_BAR_WORDS) * 4, stream);
    Args a{};
    for (int i = 0; i < 32; ++i) a.in[i] = (const float*)d_in[i];
    a.out = (float*)d_out; a.ws = (unsigned char*)d_ws;
#if MK_PER_PHASE
    for (int p = 0; p < N_PHASES; ++p) {
        a.ph_lo = p; a.ph_hi = p + 1;
        if (p == 0) launch_range<1>(a, grid, stream);
        else if (p == 1) launch_range<2>(a, grid, stream);
        else if (p == 2) launch_range<4>(a, grid, stream);
        else { const int L = (p - 3) / 7, k = (p - 3) % 7;
            if (k == 0) launch_range<8>(a, grid, stream);
            else if (k == 1) { if (L == 0) launch_range<16>(a, grid, stream); else if (L == 1) launch_range<32>(a, grid, stream); else if (L == 2) launch_range<64>(a, grid, stream); else launch_range<128>(a, grid, stream); }
            else if (k == 2) launch_range<256>(a, grid, stream);
            else if (k == 3 || k == 6) launch_range<4>(a, grid, stream);
            else if (k == 4) launch_range<512>(a, grid, stream);
            else launch_range<1024>(a, grid, stream);
        }
    }
#else
    a.ph_lo = 0; a.ph_hi = N_PHASES; launch_range<FULLMASK>(a, grid, stream);
#endif
    const hipError_t le = hipPeekAtLastError();
    if (le != hipSuccess) fprintf(stderr, "kernel_launch: launch failed: %s\n", hipGetErrorName(le));
}
```
